# Optimizing an MI355X kernel written in HIP

```python
import math
import jax
import jax.numpy as jnp
from jax import lax
import numpy as np

D_MODEL = 1024
BATCH = 8
SEQ = 2048
DEPTH = 4

CTX_LEN = 256
GRID_W = 64
RMS_EPS = 1e-6
N_MOD = 9
D_FF = 2816

A_HEADS = 4
A_HEAD_DIM = 64
A_WIDTH = A_HEADS * A_HEAD_DIM
GLR_CHUNK = 16
B_Q_HEADS = 8
B_KV_HEADS = 2
B_GROUP = B_Q_HEADS // B_KV_HEADS
B_HEAD_DIM = 64
B_WIDTH = B_Q_HEADS * B_HEAD_DIM
B_KV_WIDTH = B_KV_HEADS * B_HEAD_DIM
WINDOW = 128
ATTN_BLOCK = 128
ROPE_BASE = 10000.0
ROPE_PAIRS = B_HEAD_DIM // 4
MASK_VALUE = -1e9
C_GROUPS = 16
C_GROUP_CH = 16
C_WIDTH = C_GROUPS * C_GROUP_CH
C_STATE = 64

D_MIX = A_WIDTH + B_WIDTH + C_WIDTH
IN_WIDTHS = (A_WIDTH, A_WIDTH, A_WIDTH, A_WIDTH, A_WIDTH, B_WIDTH, B_KV_WIDTH, B_KV_WIDTH, C_WIDTH)
D_IN = sum(IN_WIDTHS)

kernel_name = 'hybrid_hgrn2_swa_s5_macaron_adaln'


def rms_norm(x, g):
    x32 = x.astype(jnp.float32)
    y = x32 * lax.rsqrt(jnp.mean(x32 * x32, axis=-1, keepdims=True) + RMS_EPS)
    return (y * g.astype(jnp.float32)).astype(x.dtype)


def adaln(h, g, m, i):
    return rms_norm(h, g) * (1 + m[:, :, i, 1]) + m[:, :, i, 0]


def swiglu(h, w1, w2):
    gate, up = jnp.split(h @ w1, 2, axis=-1)
    return (jax.nn.silu(gate) * up) @ w2


def split_columns(p):
    points, acc = [], 0
    for w in IN_WIDTHS[:-1]:
        acc += w
        points.append(acc)
    return jnp.split(p, points, axis=-1)


def axial_rope_tables(length):
    rows = length // GRID_W
    row = jnp.repeat(jnp.arange(rows), GRID_W, total_repeat_length=length)
    col = jnp.tile(jnp.arange(GRID_W), rows)
    inv_freq = ROPE_BASE ** (-jnp.arange(ROPE_PAIRS, dtype=jnp.float32) / ROPE_PAIRS)
    ang = jnp.stack([row.astype(jnp.float32)[:, None] * inv_freq,
                     col.astype(jnp.float32)[:, None] * inv_freq], axis=1)
    return jnp.cos(ang), jnp.sin(ang)


def apply_axial_rope(x, cos, sin):
    b, l, h, d = x.shape
    xr = x.reshape(b, l, h, 2, 2, d // 4)
    x1, x2 = xr[..., 0, :], xr[..., 1, :]
    c = cos[None, :, None].astype(x.dtype)
    s = sin[None, :, None].astype(x.dtype)
    out = jnp.stack([x1 * c - x2 * s, x2 * c + x1 * s], axis=-2)
    return out.reshape(b, l, h, d)


def hgrn2_gates(z, lb):
    z32 = z.astype(jnp.float32)
    f = lb + (1.0 - lb) * jax.nn.sigmoid(z32)
    logf = jnp.log(f)
    k = (1.0 - lb) * jax.nn.sigmoid(-z32)
    return logf, k


def to_heads(a):
    bsz, length, _ = a.shape
    return a.astype(jnp.float32).reshape(bsz, length, A_HEADS, A_HEAD_DIM).transpose(0, 2, 1, 3)


def gated_linear_recurrence(q, k, v, logf, s0):
    bsz, h, length, dk = q.shape
    dv = v.shape[-1]
    n = length // GLR_CHUNK
    q, k, logf = (a.reshape(bsz, h, n, GLR_CHUNK, dk) for a in (q, k, logf))
    v = v.reshape(bsz, h, n, GLR_CHUNK, dv)
    b = jnp.cumsum(logf, axis=3)
    b_last = b[:, :, :, -1]
    u = jnp.einsum('bhnsk,bhnsv->bhnkv', k * jnp.exp(b_last[:, :, :, None] - b), v)

    def step(s, inp):
        dec, un = inp
        return dec[..., None] * s + un, s

    s_fin, s_start = lax.scan(step, s0, (jnp.moveaxis(jnp.exp(b_last), 2, 0), jnp.moveaxis(u, 2, 0)))
    s_start = jnp.moveaxis(s_start, 0, 2)
    o_inter = jnp.einsum('bhntk,bhnkv->bhntv', q * jnp.exp(b), s_start)
    lower = jnp.tril(jnp.ones((GLR_CHUNK, GLR_CHUNK), dtype=bool))[..., None]
    diff = b[:, :, :, :, None, :] - b[:, :, :, None, :, :]
    decay = jnp.where(lower, jnp.exp(jnp.where(lower, diff, 0.0)), 0.0)
    scores = jnp.einsum('bhntk,bhnsk,bhntsk->bhnts', q, k, decay)
    o = o_inter + jnp.einsum('bhnts,bhnsv->bhntv', scores, v)
    return o.reshape(bsz, h, length, dv), s_fin


def hgrn2_direction(lat, ctx_side, reverse):
    if reverse:
        lat = [jnp.flip(a, axis=2) for a in lat]
        ctx_side = [jnp.flip(a, axis=2) for a in ctx_side]
    qc, kc, vc, logfc = ctx_side
    s0 = jnp.zeros(qc.shape[:2] + (A_HEAD_DIM, A_HEAD_DIM), jnp.float32)
    oc, s_ctx = gated_linear_recurrence(qc, kc, vc, logfc, s0)
    o, _ = gated_linear_recurrence(lat[0], lat[1], lat[2], lat[3], s_ctx)
    if reverse:
        o, oc = jnp.flip(o, axis=2), jnp.flip(oc, axis=2)
    return o, oc


def hgrn2_readout(o, g, norm_g):
    o = o * lax.rsqrt(jnp.mean(o * o, axis=-1, keepdims=True) + RMS_EPS)
    bsz, _, length, _ = o.shape
    o = o.transpose(0, 2, 1, 3).reshape(bsz, length, A_WIDTH)
    return (o * norm_g.astype(jnp.float32) * jax.nn.silu(g.astype(jnp.float32))).astype(g.dtype)


def hgrn2_mixer(lat, ctx_side, lb, norm_g):
    q, v, zf, zb, g = lat
    qc, vc, zfc, zbc, gc = ctx_side
    q_h, v_h = to_heads(jax.nn.silu(q)), to_heads(v)
    qc_h, vc_h = to_heads(jax.nn.silu(qc)), to_heads(vc)
    logf_f, k_f = hgrn2_gates(zf, lb[0])
    logfc_f, kc_f = hgrn2_gates(zfc, lb[0])
    logf_b, k_b = hgrn2_gates(zb, lb[1])
    logfc_b, kc_b = hgrn2_gates(zbc, lb[1])
    o_f, oc_f = hgrn2_direction([q_h, to_heads(k_f), v_h, to_heads(logf_f)],
                                [qc_h, to_heads(kc_f), vc_h, to_heads(logfc_f)], False)
    o_b, oc_b = hgrn2_direction([q_h, to_heads(k_b), v_h, to_heads(logf_b)],
                                [qc_h, to_heads(kc_b), vc_h, to_heads(logfc_b)], True)
    return hgrn2_readout(o_f + o_b, g, norm_g), hgrn2_readout(oc_f + oc_b, gc, norm_g)


def sink_softmax(logits, sink):
    s = sink.astype(jnp.float32).reshape((1,) + sink.shape + (1,) * (logits.ndim - 3))
    s = jnp.broadcast_to(s, logits.shape[:-1] + (1,))
    p = jax.nn.softmax(jnp.concatenate([logits, s], axis=-1), axis=-1)
    return p[..., :-1]


def window_gqa_mixer(lat, ctx_side, sink, cos, sin):
    q, k, v = lat
    qc, kc, vc = ctx_side
    bsz, length, _ = q.shape
    lc = qc.shape[1]
    nb = length // ATTN_BLOCK
    band = 3 * ATTN_BLOCK
    scale = B_HEAD_DIM ** -0.5
    sink_g = sink.reshape(B_KV_HEADS, B_GROUP)
    q = apply_axial_rope(q.reshape(bsz, length, B_Q_HEADS, B_HEAD_DIM), cos, sin)
    k = apply_axial_rope(k.reshape(bsz, length, B_KV_HEADS, B_HEAD_DIM), cos, sin)
    v = v.reshape(bsz, length, B_KV_HEADS, B_HEAD_DIM)
    qc = qc.reshape(bsz, lc, B_KV_HEADS, B_GROUP, B_HEAD_DIM)
    kc = kc.reshape(bsz, lc, B_KV_HEADS, B_HEAD_DIM)
    vc = vc.reshape(bsz, lc, B_KV_HEADS, B_HEAD_DIM)
    qb = q.reshape(bsz, nb, ATTN_BLOCK, B_KV_HEADS, B_GROUP, B_HEAD_DIM)
    idx = jnp.arange(nb)[:, None] * ATTN_BLOCK + jnp.arange(band)[None, :]
    pad = ((0, 0), (ATTN_BLOCK, ATTN_BLOCK), (0, 0), (0, 0))
    kb = jnp.pad(k, pad)[:, idx]
    vb = jnp.pad(v, pad)[:, idx]
    s_loc = jnp.einsum('bnqhgd,bnkhd->bhgnqk', qb, kb).astype(jnp.float32) * scale
    s_ctx = jnp.einsum('bnqhgd,bkhd->bhgnqk', qb, kc).astype(jnp.float32) * scale
    t_pos = jnp.arange(nb)[:, None, None] * ATTN_BLOCK + jnp.arange(ATTN_BLOCK)[None, :, None]
    s_pos = jnp.arange(nb)[:, None, None] * ATTN_BLOCK - ATTN_BLOCK + jnp.arange(band)[None, None, :]
    valid = (jnp.abs(t_pos - s_pos) <= WINDOW) & (s_pos >= 0) & (s_pos < length)
    s_loc = jnp.where(valid, s_loc, MASK_VALUE)
    p = sink_softmax(jnp.concatenate([s_loc, s_ctx], axis=-1), sink_g).astype(v.dtype)
    o = (jnp.einsum('bhgnqk,bnkhd->bnqhgd', p[..., :band], vb)
         + jnp.einsum('bhgnqk,bkhd->bnqhgd', p[..., band:], vc))
    o = o.reshape(bsz, length, B_WIDTH)
    sc = jnp.einsum('bqhgd,bkhd->bhgqk', qc, kc).astype(jnp.float32) * scale
    pc = sink_softmax(sc, sink_g).astype(vc.dtype)
    oc = jnp.einsum('bhgqk,bkhd->bqhgd', pc, vc).reshape(bsz, lc, B_WIDTH)
    return o, oc


def zoh_discretise(a_re, a_im, log_dt, b_re, b_im):
    dt = jnp.exp(log_dt)[:, None]
    mag = jnp.exp(a_re * dt)
    ang = a_im * dt
    abar_re, abar_im = mag * jnp.cos(ang), mag * jnp.sin(ang)
    den = a_re * a_re + a_im * a_im
    coef_re = ((abar_re - 1.0) * a_re + abar_im * a_im) / den
    coef_im = (abar_im * a_re - (abar_re - 1.0) * a_im) / den
    bbar_re = coef_re[..., None] * b_re - coef_im[..., None] * b_im
    bbar_im = coef_re[..., None] * b_im + coef_im[..., None] * b_re
    return abar_re, abar_im, bbar_re, bbar_im


def diagonal_scan(abar_re, abar_im, bu_re, bu_im, h0_re, h0_im):
    bu_re = bu_re.at[:, 0].add(abar_re * h0_re - abar_im * h0_im)
    bu_im = bu_im.at[:, 0].add(abar_re * h0_im + abar_im * h0_re)
    a_re = jnp.broadcast_to(abar_re, bu_re.shape)
    a_im = jnp.broadcast_to(abar_im, bu_im.shape)

    def combine(e1, e2):
        a1r, a1i, b1r, b1i = e1
        a2r, a2i, b2r, b2i = e2
        return (a2r * a1r - a2i * a1i, a2r * a1i + a2i * a1r,
                a2r * b1r - a2i * b1i + b2r, a2r * b1i + a2i * b1r + b2i)

    _, _, h_re, h_im = lax.associative_scan(combine, (a_re, a_im, bu_re, bu_im), axis=1)
    return h_re, h_im


def s5_direction(ug, ugc, abar_re, abar_im, bbar_re, bbar_im, c_re, c_im, reverse):
    if reverse:
        ug, ugc = jnp.flip(ug, axis=1), jnp.flip(ugc, axis=1)

    def drive(u):
        return (jnp.einsum('blgc,gpc->blgp', u, bbar_re), jnp.einsum('blgc,gpc->blgp', u, bbar_im))

    def readout(h_re, h_im):
        return jnp.einsum('blgp,gcp->blgc', h_re, c_re) - jnp.einsum('blgp,gcp->blgc', h_im, c_im)

    h0 = jnp.zeros((ugc.shape[0], C_GROUPS, C_STATE), jnp.float32)
    hc_re, hc_im = diagonal_scan(abar_re, abar_im, *drive(ugc), h0, h0)
    h_re, h_im = diagonal_scan(abar_re, abar_im, *drive(ug), hc_re[:, -1], hc_im[:, -1])
    y, yc = readout(h_re, h_im), readout(hc_re, hc_im)
    if reverse:
        y, yc = jnp.flip(y, axis=1), jnp.flip(yc, axis=1)
    return y, yc


def s5_mixer(u, uc, a_re, a_im, log_dt, b_re, b_im, c_re, c_im, d, glu_w, glu_b):
    f32 = jnp.float32
    bsz, length, _ = u.shape
    lc = uc.shape[1]
    u32, uc32 = u.astype(f32), uc.astype(f32)
    ug = u32.reshape(bsz, length, C_GROUPS, C_GROUP_CH)
    ugc = uc32.reshape(bsz, lc, C_GROUPS, C_GROUP_CH)
    y = d.astype(f32) * u32
    yc = d.astype(f32) * uc32
    for k, rev in ((0, False), (1, True)):
        disc = zoh_discretise(a_re[k].astype(f32), a_im[k].astype(f32), log_dt[k].astype(f32),
                              b_re.astype(f32), b_im.astype(f32))
        yk, yck = s5_direction(ug, ugc, *disc, c_re[k].astype(f32), c_im[k].astype(f32), rev)
        y = y + yk.reshape(bsz, length, C_WIDTH)
        yc = yc + yck.reshape(bsz, lc, C_WIDTH)

    def glu(h):
        a, b = jnp.split(jax.nn.gelu(h) @ glu_w.astype(f32) + glu_b.astype(f32), 2, axis=-1)
        return (a * jax.nn.sigmoid(b)).astype(u.dtype)

    return glu(y), glu(yc)


def setup_inputs(seed: int = 0) -> dict:
    key = jax.random.key(seed)
    ks = jax.random.split(key, 25)
    f32 = jnp.float32

    def nrm(k, shape, scale):
        return scale * jax.random.normal(k, shape, f32)

    n_idx = jnp.arange(C_STATE, dtype=f32)
    return {
        'x': nrm(ks[0], (BATCH, SEQ, D_MODEL), 1.0),
        'c': nrm(ks[1], (BATCH, D_MODEL), 1.0),
        'ctx': nrm(ks[2], (BATCH, CTX_LEN, D_MODEL), 1.0),
        'c_ctx': nrm(ks[3], (D_MODEL,), 1.0),
        'ada_w': nrm(ks[4], (DEPTH, D_MODEL, N_MOD * D_MODEL), 0.5 * D_MODEL ** -0.5),
        'ada_b': nrm(ks[5], (DEPTH, N_MOD * D_MODEL), 0.02),
        'norm_g': 1.0 + nrm(ks[6], (DEPTH, 3, D_MODEL), 0.01),
        'ffn_w1': nrm(ks[7], (DEPTH, 2, D_MODEL, 2 * D_FF), D_MODEL ** -0.5),
        'ffn_w2': nrm(ks[8], (DEPTH, 2, D_FF, D_MODEL), D_FF ** -0.5),
        'w_in': nrm(ks[9], (DEPTH, D_MODEL, D_IN), D_MODEL ** -0.5),
        'w_out': nrm(ks[10], (DEPTH, D_MIX, D_MODEL), D_MIX ** -0.5),
        'hgrn_lower_bounds': nrm(ks[11], (DEPTH, 2, A_WIDTH), 0.1),
        'hgrn_norm_g': 1.0 + nrm(ks[12], (DEPTH, A_WIDTH), 0.01),
        'attn_sink': nrm(ks[13], (DEPTH, B_Q_HEADS), 0.1),
        's5_a_re': -0.5 + nrm(ks[14], (DEPTH, 2, C_GROUPS, C_STATE), 0.01),
        's5_a_im': math.pi * n_idx + nrm(ks[15], (DEPTH, 2, C_GROUPS, C_STATE), 0.01),
        's5_log_dt': jax.random.uniform(ks[16], (DEPTH, 2, C_GROUPS), f32, math.log(1e-3), math.log(1e-1)),
        's5_b_re': nrm(ks[17], (DEPTH, C_GROUPS, C_STATE, C_GROUP_CH), (2 * C_GROUP_CH) ** -0.5),
        's5_b_im': nrm(ks[18], (DEPTH, C_GROUPS, C_STATE, C_GROUP_CH), (2 * C_GROUP_CH) ** -0.5),
        's5_c_re': nrm(ks[19], (DEPTH, 2, C_GROUPS, C_GROUP_CH, C_STATE), C_STATE ** -0.5),
        's5_c_im': nrm(ks[20], (DEPTH, 2, C_GROUPS, C_GROUP_CH, C_STATE), C_STATE ** -0.5),
        's5_d': nrm(ks[21], (DEPTH, C_WIDTH), 1.0),
        's5_glu_w': nrm(ks[22], (DEPTH, C_WIDTH, 2 * C_WIDTH), C_WIDTH ** -0.5),
        's5_glu_b': nrm(ks[23], (DEPTH, 2 * C_WIDTH), 0.02),
        'final_norm_g': 1.0 + nrm(ks[24], (D_MODEL,), 0.01),
    }


def reference(x, c, ctx, c_ctx, ada_w, ada_b, norm_g, ffn_w1, ffn_w2, w_in, w_out,
              hgrn_lower_bounds, hgrn_norm_g, attn_sink, s5_a_re, s5_a_im, s5_log_dt,
              s5_b_re, s5_b_im, s5_c_re, s5_c_im, s5_d, s5_glu_w, s5_glu_b, final_norm_g):
    bsz, seq_len, d = x.shape
    cos, sin = axial_rope_tables(seq_len)
    lb_soft = jax.nn.softmax(hgrn_lower_bounds.astype(jnp.float32), axis=0)
    lower_bound = jnp.cumsum(lb_soft, axis=0) - lb_soft[0]
    act_c = jax.nn.silu(c)
    act_cc = jax.nn.silu(c_ctx)
    xc = ctx
    for l in range(DEPTH):
        mod_x = (act_c @ ada_w[l] + ada_b[l]).reshape(bsz, 1, 3, 3, d)
        mod_c = (act_cc @ ada_w[l] + ada_b[l]).reshape(1, 1, 3, 3, d)
        x = x + 0.5 * mod_x[:, :, 0, 2] * swiglu(adaln(x, norm_g[l, 0], mod_x, 0), ffn_w1[l, 0], ffn_w2[l, 0])
        xc = xc + 0.5 * mod_c[:, :, 0, 2] * swiglu(adaln(xc, norm_g[l, 0], mod_c, 0), ffn_w1[l, 0], ffn_w2[l, 0])
        px = split_columns(adaln(x, norm_g[l, 1], mod_x, 1) @ w_in[l])
        pc = split_columns(adaln(xc, norm_g[l, 1], mod_c, 1) @ w_in[l])
        a_x, a_c = hgrn2_mixer(px[0:5], pc[0:5], lower_bound[l], hgrn_norm_g[l])
        b_x, b_c = window_gqa_mixer(px[5:8], pc[5:8], attn_sink[l], cos, sin)
        c_x, c_c = s5_mixer(px[8], pc[8], s5_a_re[l], s5_a_im[l], s5_log_dt[l], s5_b_re[l], s5_b_im[l],
                            s5_c_re[l], s5_c_im[l], s5_d[l], s5_glu_w[l], s5_glu_b[l])
        x = x + mod_x[:, :, 1, 2] * (jnp.concatenate([a_x, b_x, c_x], axis=-1) @ w_out[l])
        if l < DEPTH - 1:
            xc = xc + mod_c[:, :, 1, 2] * (jnp.concatenate([a_c, b_c, c_c], axis=-1) @ w_out[l])
            xc = xc + 0.5 * mod_c[:, :, 2, 2] * swiglu(adaln(xc, norm_g[l, 2], mod_c, 2), ffn_w1[l, 1], ffn_w2[l, 1])
        x = x + 0.5 * mod_x[:, :, 2, 2] * swiglu(adaln(x, norm_g[l, 2], mod_x, 2), ffn_w1[l, 1], ffn_w2[l, 1])
    return rms_norm(x, final_norm_g)
```

```cpp
#include <hip/hip_runtime.h>
#include <hip/hip_cooperative_groups.h>
#include <cstdio>
namespace cg = cooperative_groups;

typedef unsigned short bf16_t;
typedef short bf16x8 __attribute__((ext_vector_type(8)));
typedef short s16x4 __attribute__((ext_vector_type(4)));
typedef float f32x4 __attribute__((ext_vector_type(4)));
typedef float f32x16 __attribute__((ext_vector_type(16)));
#define DEVI __device__ __forceinline__

constexpr int NLAT = 16384, NCTX = 2048, NROW = 18432, DM = 1024, DFF = 2816, DIN = 2304;
constexpr int NTHR = 512;
constexpr int LDS_BYTES = 131072 + 256;

constexpr size_t OFF_X    = 0;
constexpr size_t OFF_H    = OFF_X    + (size_t)NROW * DM * 4;
constexpr size_t OFF_P    = OFF_H    + (size_t)NROW * DM * 2;
constexpr size_t OFF_MIX  = OFF_P    + (size_t)NROW * DIN * 4;
constexpr size_t OFF_OA   = OFF_MIX  + (size_t)NROW * DM * 2;
constexpr size_t OFF_YS   = OFF_OA   + (size_t)2 * NROW * 256 * 4;
constexpr size_t OFF_GA   = OFF_YS   + (size_t)2 * NROW * 256 * 4;
constexpr size_t OFF_W1T  = OFF_GA   + (size_t)NROW * 256 * 2;
constexpr size_t OFF_W2T  = OFF_W1T  + (size_t)8 * 5632 * 1024 * 2;
constexpr size_t OFF_WINT = OFF_W2T  + (size_t)8 * 1024 * 2816 * 2;
constexpr size_t OFF_WOT  = OFF_WINT + (size_t)4 * 2304 * 1024 * 2;
constexpr size_t OFF_GLUT = OFF_WOT  + (size_t)4 * 1024 * 1024 * 2;
constexpr size_t OFF_MOD  = OFF_GLUT + (size_t)4 * 512 * 256 * 2;
constexpr size_t OFF_ABAR = OFF_MOD  + (size_t)4 * 9 * 9216 * 4;
constexpr size_t OFF_BBAR = OFF_ABAR + (size_t)8192 * 2 * 4;
constexpr size_t OFF_LB   = OFF_BBAR + (size_t)8192 * 32 * 4;
constexpr size_t OFF_ROPE = OFF_LB   + (size_t)4 * 512 * 4;
constexpr size_t OFF_CNT  = OFF_ROPE + (size_t)2048 * 4;
constexpr size_t OFF_BAR  = OFF_CNT  + 256;
constexpr size_t OFF_PART = (OFF_BAR + 5504 * 4 + 255) / 256 * 256;
constexpr size_t OFF_ACT  = OFF_PART + (size_t)4 * NCTX * DM * 4;
constexpr size_t WS_END   = OFF_ACT  + (size_t)NROW * DFF * 2;

struct Grp { int gi, nx, rank, nloc; };
struct Params {
  const float *x, *c, *ctx, *c_ctx, *ada_w, *ada_b, *norm_g, *ffn_w1, *ffn_w2, *w_in, *w_out, *lbnd, *hnorm_g, *sink;
  const float *a_re, *a_im, *log_dt, *b_re, *b_im, *c_re, *c_im, *s5_d, *glu_w, *glu_b, *final_g;
  float* out;
  unsigned char* ws;
};

DEVI unsigned short f2bf(float x) { const __bf16 b = (__bf16)x; return __builtin_bit_cast(unsigned short, b); }
DEVI float silu_f(float x) { return x * __builtin_amdgcn_rcpf(1.f + __expf(-x)); }
DEVI float shx(float v, int k, int lane) { return __int_as_float(__builtin_amdgcn_ds_bpermute((lane ^ k) << 2, __float_as_int(v))); }
DEVI float wave_sum(float v, int lane) { for (int o = 32; o > 0; o >>= 1) v += shx(v, o, lane); return v; }

DEVI void transpose_tile(const float* __restrict__ src, bf16_t* __restrict__ dst, int K, int N, int k0, int n0, int drow0, float* T) {
  const int tid = threadIdx.x;
  { const int r = tid >> 4, c4 = tid & 15;
    for (int rr = r; rr < 64; rr += 32) {
      const float4 v = *(const float4*)(src + (size_t)(k0 + rr) * N + n0 + c4 * 4);
      T[rr * 65 + c4 * 4 + 0] = v.x; T[rr * 65 + c4 * 4 + 1] = v.y; T[rr * 65 + c4 * 4 + 2] = v.z; T[rr * 65 + c4 * 4 + 3] = v.w;
    } }
  __syncthreads();
  { const int n = tid >> 3, k8 = tid & 7;
    bf16x8 o;
#pragma unroll
    for (int i = 0; i < 8; ++i) o[i] = (short)f2bf(T[(k8 * 8 + i) * 65 + n]);
    *(bf16x8*)(dst + (size_t)(drow0 + n) * K + k0 + k8 * 8) = o; }
  __syncthreads();
}
DEVI int perm_row(int n0, int half) { const int hi = n0 >= half; const int j0 = n0 - hi * half; return (j0 >> 7) * 256 + hi * 128 + (j0 & 127); }

__device__ void phase0(const Params& p) {
  extern __shared__ __attribute__((aligned(16))) unsigned char lds_raw[];
  float* L = (float*)lds_raw;
  const int tid = threadIdx.x, nb = gridDim.x, bid = blockIdx.x;
  if (bid == 0) { if (tid < 64) ((int*)(p.ws + OFF_CNT))[tid] = 0; for (int i = tid; i < 5504; i += NTHR) ((unsigned*)(p.ws + OFF_BAR))[i] = 0u; }
  { const int gi = bid * NTHR + tid, gs = nb * NTHR;
    float* rc = (float*)(p.ws + OFF_ROPE); float* rs = rc + 1024;
    for (int e = gi; e < 1024; e += gs) { const int pos = e >> 4, i = e & 15; const float inv = powf(10000.f, -(float)i / 16.f); const float a = (float)pos * inv; rc[e] = cosf(a); rs[e] = sinf(a); }
    float* lb = (float*)(p.ws + OFF_LB);
    for (int e = gi; e < 512; e += gs) {
      const float v0 = p.lbnd[e], v1 = p.lbnd[512 + e], v2 = p.lbnd[1024 + e], v3 = p.lbnd[1536 + e];
      const float mx = fmaxf(fmaxf(v0, v1), fmaxf(v2, v3));
      const float e0 = expf(v0 - mx), e1 = expf(v1 - mx), e2 = expf(v2 - mx), e3 = expf(v3 - mx);
      const float inv = 1.f / (e0 + e1 + e2 + e3);
      lb[e] = 0.f; lb[512 + e] = e1 * inv; lb[1024 + e] = (e1 + e2) * inv; lb[1536 + e] = (e1 + e2 + e3) * inv;
    }
    float* ab = (float*)(p.ws + OFF_ABAR); float* bb = (float*)(p.ws + OFF_BBAR);
    for (int e = gi; e < 8192; e += gs) {
      const int pp = e & 63, g = (e >> 6) & 15, l = e >> 11;
      const float are = p.a_re[e], aim = p.a_im[e];
      const float dt = expf(p.log_dt[e >> 6]);
      const float mag = expf(are * dt), ang = aim * dt;
      const float abr = mag * cosf(ang), abi = mag * sinf(ang);
      const float den = are * are + aim * aim;
      const float cr = ((abr - 1.f) * are + abi * aim) / den;
      const float ci = (abi * are - (abr - 1.f) * aim) / den;
      ab[e * 2] = abr; ab[e * 2 + 1] = abi;
      const float* br = p.b_re + ((size_t)(l * 16 + g) * 64 + pp) * 16; const float* bi = p.b_im + ((size_t)(l * 16 + g) * 64 + pp) * 16;
      for (int c = 0; c < 16; ++c) { const float r = br[c], i2 = bi[c]; bb[((size_t)((e >> 6) * 2 + 0) * 64 + pp) * 16 + c] = cr * r - ci * i2; bb[((size_t)((e >> 6) * 2 + 1) * 64 + pp) * 16 + c] = cr * i2 + ci * r; }
    }
  }
  constexpr int N_MOD = 144;
  if (bid < N_MOD) {
    const int it = bid;
    float* SC = L; float* RED = L + 9216;
    for (int e = tid; e < 9216; e += NTHR) { const int r = e >> 10, k = e & 1023; const float v = (r < 8) ? p.c[r * 1024 + k] : p.c_ctx[k]; SC[e] = silu_f(v); }
    __syncthreads();
    const int cb = it * 256, l = cb / 9216, n0 = cb % 9216;
    const int cq = tid & 63, kg = tid >> 6;
    float acc[9][4];
#pragma unroll
    for (int r = 0; r < 9; ++r) { acc[r][0] = 0.f; acc[r][1] = 0.f; acc[r][2] = 0.f; acc[r][3] = 0.f; }
    const float* wp = p.ada_w + ((size_t)l * 1024 + kg * 128) * 9216 + n0 + cq * 4;
#pragma unroll 8
    for (int kk = 0; kk < 128; ++kk) {
      const float4 w = *(const float4*)(wp + (size_t)kk * 9216);
#pragma unroll
      for (int r = 0; r < 9; ++r) { const float s = SC[r * 1024 + kg * 128 + kk]; acc[r][0] += s * w.x; acc[r][1] += s * w.y; acc[r][2] += s * w.z; acc[r][3] += s * w.w; }
    }
#pragma unroll
    for (int r = 0; r < 9; ++r) *(float4*)(RED + (kg * 9 + r) * 256 + cq * 4) = make_float4(acc[r][0], acc[r][1], acc[r][2], acc[r][3]);
    __syncthreads();
    float* mod = (float*)(p.ws + OFF_MOD);
    for (int e = tid; e < 2304; e += NTHR) {
      const int r = e >> 8, cc = e & 255; float s = p.ada_b[l * 9216 + n0 + cc];
      for (int k2 = 0; k2 < 8; ++k2) s += RED[(k2 * 9 + r) * 256 + cc];
      mod[(size_t)(l * 9 + r) * 9216 + n0 + cc] = s;
    }
    __syncthreads();
  }
  {
    constexpr int T_W1 = 8 * 16 * 22, T_W2 = 8 * 44 * 4, T_WIN = 4 * 16 * 9, T_WO = 4 * 16 * 4, T_GLU = 4 * 4 * 2;
    constexpr int N_TR = T_W1 + T_W2 + T_WIN + T_WO + T_GLU;
    float* T = L;
    for (int t0 = bid; t0 < N_TR; t0 += nb) {
      int t = t0; const float* srcp; bf16_t* dstp; int K, N, k0, n0, half;
      if (t < T_W1) { const int mat = t / 352, tl = t % 352; k0 = (tl / 22) * 64; n0 = (tl % 22) * 256; K = 1024; N = 5632; half = 2816;
        srcp = p.ffn_w1 + (size_t)mat * 1024 * 5632; dstp = (bf16_t*)(p.ws + OFF_W1T) + (size_t)mat * 5632 * 1024;
      } else if ((t -= T_W1) < T_W2) { const int mat = t / 176, tl = t % 176; k0 = (tl / 4) * 64; n0 = (tl % 4) * 256; K = 2816; N = 1024; half = 0;
        srcp = p.ffn_w2 + (size_t)mat * 2816 * 1024; dstp = (bf16_t*)(p.ws + OFF_W2T) + (size_t)mat * 1024 * 2816;
      } else if ((t -= T_W2) < T_WIN) { const int mat = t / 144, tl = t % 144; k0 = (tl / 9) * 64; n0 = (tl % 9) * 256; K = 1024; N = 2304; half = 0;
        srcp = p.w_in + (size_t)mat * 1024 * 2304; dstp = (bf16_t*)(p.ws + OFF_WINT) + (size_t)mat * 2304 * 1024;
      } else if ((t -= T_WIN) < T_WO) { const int mat = t / 64, tl = t % 64; k0 = (tl / 4) * 64; n0 = (tl % 4) * 256; K = 1024; N = 1024; half = 0;
        srcp = p.w_out + (size_t)mat * 1024 * 1024; dstp = (bf16_t*)(p.ws + OFF_WOT) + (size_t)mat * 1024 * 1024;
      } else { t -= T_WO; const int mat = t / 8, tl = t % 8; k0 = (tl / 2) * 64; n0 = (tl % 2) * 256; K = 256; N = 512; half = 256;
        srcp = p.glu_w + (size_t)mat * 256 * 512; dstp = (bf16_t*)(p.ws + OFF_GLUT) + (size_t)mat * 512 * 256;
      }
      { const int r = tid >> 6, c4 = tid & 63;
        float4 v[8];
#pragma unroll
        for (int i = 0; i < 8; ++i) v[i] = *(const float4*)(srcp + (size_t)(k0 + r + 8 * i) * N + n0 + c4 * 4);
#pragma unroll
        for (int i = 0; i < 8; ++i) { float* tp = T + (r + 8 * i) * 257 + c4 * 4; tp[0] = v[i].x; tp[1] = v[i].y; tp[2] = v[i].z; tp[3] = v[i].w; } }
      __syncthreads();
      { const int nn = tid >> 1, kh = tid & 1;
        const int ng = n0 + (nn & 128);
        const int drow = (half ? perm_row(ng, half) : ng) + (nn & 127);
#pragma unroll
        for (int q = 0; q < 4; ++q) {
          const int k8 = kh * 4 + q; bf16x8 o;
#pragma unroll
          for (int i = 0; i < 8; ++i) o[i] = (short)f2bf(T[(k8 * 8 + i) * 257 + nn]);
          *(bf16x8*)(dstp + (size_t)drow * K + k0 + k8 * 8) = o;
        } }
      __syncthreads();
    }
  }
}

__device__ void phase_adaln(const Params& p, const Grp gr, int l, int i, int nrows, const float* pend_gate, const float pend_coef, const float* xlat, const float* xctx) {
  int tid0 = threadIdx.x; asm volatile("" : "+v"(tid0));
  const int lane = tid0 & 63, gw = blockIdx.x * 8 + (tid0 >> 6), nw = gridDim.x * 8;
  float* X = (float*)(p.ws + OFF_X); bf16_t* H = (bf16_t*)(p.ws + OFF_H);
  const float* PART = (const float*)(p.ws + OFF_PART);
  const float* g = p.norm_g + (size_t)(l * 3 + i) * 1024;
  const int lw = gr.rank * 8 + (tid0 >> 6), nlw = gr.nloc * 8;
  const int per_b = (nrows > NLAT) ? 2304 : 2048;
  for (int xb = gr.gi; xb < 8; xb += gr.nx)
  for (int it = lw; it < per_b; it += nlw) {
    const int row = (it < 2048) ? xb * 2048 + it : NLAT + xb * 256 + (it - 2048);
    const int mr = (row < NLAT) ? (row >> 11) : 8;
    const float* mod = (const float*)(p.ws + OFF_MOD) + (size_t)(l * 9 + mr) * 9216 + i * 3072;
    float4 v[4]; float ss = 0.f;
    const float* xr = (row < NLAT) ? (xlat ? xlat + (size_t)row * 1024 : X + (size_t)row * 1024) : (xctx ? xctx + (size_t)(row - NLAT) * 1024 : X + (size_t)row * 1024);
#pragma unroll
    for (int q = 0; q < 4; ++q) v[q] = *(const float4*)(xr + q * 256 + lane * 4);
    if (pend_gate != nullptr && row >= NLAT) {
#pragma unroll
      for (int q = 0; q < 4; ++q) {
        const int col = q * 256 + lane * 4; const size_t o = (size_t)(row - NLAT) * 1024 + col;
        const float4 a = *(const float4*)(PART + o), b = *(const float4*)(PART + (size_t)NCTX * 1024 + o), c = *(const float4*)(PART + (size_t)2 * NCTX * 1024 + o), d = *(const float4*)(PART + (size_t)3 * NCTX * 1024 + o);
        const float4 gt = *(const float4*)(pend_gate + col);
        v[q].x += pend_coef * gt.x * ((a.x + b.x) + (c.x + d.x)); v[q].y += pend_coef * gt.y * ((a.y + b.y) + (c.y + d.y));
        v[q].z += pend_coef * gt.z * ((a.z + b.z) + (c.z + d.z)); v[q].w += pend_coef * gt.w * ((a.w + b.w) + (c.w + d.w));
        *(float4*)(X + (size_t)row * 1024 + col) = v[q];
      }
    }
#pragma unroll
    for (int q = 0; q < 4; ++q) ss += v[q].x * v[q].x + v[q].y * v[q].y + v[q].z * v[q].z + v[q].w * v[q].w;
    ss = wave_sum(ss, lane);
    const float rstd = rsqrtf(ss * (1.f / 1024.f) + 1e-6f);
#pragma unroll
    for (int q = 0; q < 4; ++q) {
      const int col = q * 256 + lane * 4;
      const float4 gg = *(const float4*)(g + col), sh = *(const float4*)(mod + col), sc = *(const float4*)(mod + 1024 + col);
      s16x4 o;
      o[0] = (short)f2bf(v[q].x * rstd * gg.x * (1.f + sc.x) + sh.x); o[1] = (short)f2bf(v[q].y * rstd * gg.y * (1.f + sc.y) + sh.y);
      o[2] = (short)f2bf(v[q].z * rstd * gg.z * (1.f + sc.z) + sh.z); o[3] = (short)f2bf(v[q].w * rstd * gg.w * (1.f + sc.w) + sh.w);
      *(s16x4*)(H + (size_t)row * 1024 + col) = o;
    }
  }
}
__device__ void phase_final(const Params& p, const Grp gr) {
  int tid0 = threadIdx.x; asm volatile("" : "+v"(tid0));
  const int lane = tid0 & 63, gw = blockIdx.x * 8 + (tid0 >> 6), nw = gridDim.x * 8;
  const float* X = (const float*)(p.ws + OFF_X);
  const int lw = gr.rank * 8 + (tid0 >> 6), nlw = gr.nloc * 8;
  for (int xb = gr.gi; xb < 8; xb += gr.nx)
  for (int it = lw; it < 2048; it += nlw) {
    const int row = xb * 2048 + it;
    float4 v[4]; float ss = 0.f;
#pragma unroll
    for (int q = 0; q < 4; ++q) { v[q] = *(const float4*)(X + (size_t)row * 1024 + q * 256 + lane * 4); ss += v[q].x * v[q].x + v[q].y * v[q].y + v[q].z * v[q].z + v[q].w * v[q].w; }
    ss = wave_sum(ss, lane);
    const float rstd = rsqrtf(ss * (1.f / 1024.f) + 1e-6f);
#pragma unroll
    for (int q = 0; q < 4; ++q) {
      const int col = q * 256 + lane * 4; const float4 gg = *(const float4*)(p.final_g + col);
      *(float4*)(p.out + (size_t)row * 1024 + col) = make_float4(v[q].x * rstd * gg.x, v[q].y * rstd * gg.y, v[q].z * rstd * gg.z, v[q].w * rstd * gg.w);
    }
  }
}

constexpr int BM = 256, BK = 64, HALF = 128, HT = HALF * BK;
DEVI int lds_byte(int r, int c) { const int st = (r >> 4) * 2 + (c >> 5), rr = r & 15, cc = c & 31, ob = rr * 64 + cc * 2; return st * 1024 + (ob ^ (((ob >> 9) & 1) << 5)); }
DEVI void stage_rc(int b, int& R, int& C) { const int st = b / 1024, sb = b % 1024, swz = sb ^ (((sb >> 9) & 1) << 5); R = (st >> 1) * 16 + swz / 64; C = (st & 1) * 32 + (swz % 64) / 2; }

struct EpiArgs { float* outf; bf16_t* outb; const float* aux; float coef; int ldo; int coloff; float* part; const float* xin; };

__device__ __forceinline__ void gemm_phase(const Grp gr, const int EPI, const bf16_t* __restrict__ A, const bf16_t* __restrict__ Bt, int nM, int nN, int K, const EpiArgs ea) {
  extern __shared__ __attribute__((aligned(16))) unsigned char lds_raw[];
  bf16_t* shm = (bf16_t*)lds_raw;
#define SA(b, h) (shm + ((b) * 2 + (h)) * HT)
#define SB(b, h) (shm + (4 + (b) * 2 + (h)) * HT)
#define STAGE(P_, BASE, br, kt) do { const char* _sb = (const char*)(BASE) + ((long)(br) * K + (long)kofs + (long)(kt) * BK) * 2; \
    unsigned _v0 = voff0, _v1 = voff1; asm volatile("" : "+v"(_v0), "+v"(_v1)); \
    __builtin_amdgcn_global_load_lds((const unsigned*)(_sb + (size_t)_v0), (unsigned*)((char*)(P_) + lb0), 16, 0, 0); \
    __builtin_amdgcn_global_load_lds((const unsigned*)(_sb + (size_t)_v1), (unsigned*)((char*)(P_) + lb0 + 8192), 16, 0, 0); } while (0)
#define LDA(dst, b, h) for (int m = 0; m < 4; ++m) for (int k = 0; k < 2; ++k) \
    dst[m][k] = *reinterpret_cast<const bf16x8*>((char*)SA(b, h) + aoff + m * 2048 + k * 1024)
#define LDB(dst, b, h) for (int n = 0; n < 2; ++n) for (int k = 0; k < 2; ++k) \
    dst[n][k] = *reinterpret_cast<const bf16x8*>((char*)SB(b, h) + boff + n * 2048 + k * 1024)
#define MMA(ai, bj, At_, Bt_) do { __builtin_amdgcn_s_setprio(1); \
    for (int m = 0; m < 4; ++m) for (int n = 0; n < 2; ++n) for (int k = 0; k < 2; ++k) \
      acc[ai][bj][m][n] = __builtin_amdgcn_mfma_f32_16x16x32_bf16(Bt_[n][k], At_[m][k], acc[ai][bj][m][n], 0, 0, 0); \
    __builtin_amdgcn_s_setprio(0); } while (0)
#define WAIT_V(n) asm volatile("s_waitcnt vmcnt(" #n ")" ::: "memory")
#define WAIT_L(n) asm volatile("s_waitcnt lgkmcnt(" #n ")" ::: "memory")
#define BAR __builtin_amdgcn_s_barrier()
#define SCHED __builtin_amdgcn_sched_barrier(0)
  const int G = gridDim.x;
  int tidx = threadIdx.x; asm volatile("" : "+v"(tidx));
  const int wid = __builtin_amdgcn_readfirstlane(tidx >> 6), lane = tidx & 63, wr = wid >> 2, wc = wid & 3, fr = lane & 15, fq = lane >> 4;
  const int nt = K / BK;
  const int lb0 = tidx * 16;
  unsigned voff0, voff1;
  { int r0, c0; stage_rc(lb0, r0, c0); voff0 = (unsigned)(r0 * K + c0) * 2u; stage_rc(lb0 + 8192, r0, c0); voff1 = (unsigned)(r0 * K + c0) * 2u; }
  const int swz_l = lds_byte(fr, fq * 8);
  const int aoff = wr * 8192 + swz_l, boff = wc * 4096 + swz_l;
  const int pR = (nM > 64) ? 9 : 8;
  const bool tailk = (EPI == 2) && (pR == 9);
  const int nfullb = (tailk ? 8 : pR) * nN, Ub = nfullb + (tailk ? 4 * nN : 0);
  const int nbg = (8 - gr.gi + gr.nx - 1) / gr.nx;
  for (int unit = gr.rank; unit < nbg * Ub; unit += gr.nloc) {
    const int bsel = gr.gi + (unit / Ub) * gr.nx, u = unit % Ub;
    int pm, pn, kofs = 0, ntu = nt, split = -1;
    if (u < nfullb) {
      const int rdiv = tailk ? 8 : pR; const int rt = u % rdiv; pn = u / rdiv; pm = (rt < 8) ? 8 * bsel + rt : 64 + bsel;
    } else {
      const int q = u - nfullb; split = q & 3; pn = q >> 2; pm = 64 + bsel;
      int kt0;
      if (nt == 44) { kt0 = (split == 0) ? 0 : (split == 1) ? 12 : (split == 2) ? 24 : 34; ntu = (split < 2) ? 12 : 10; }
      else { ntu = nt >> 2; kt0 = split * ntu; }
      kofs = kt0 * BK;
    }
    const int brow = pm * BM, bcol = pn * BM;
    f32x4 acc[2][2][4][2];
#pragma unroll
    for (int a = 0; a < 2; ++a)
#pragma unroll
      for (int b = 0; b < 2; ++b)
#pragma unroll
        for (int m = 0; m < 4; ++m)
#pragma unroll
          for (int n = 0; n < 2; ++n) acc[a][b][m][n] = f32x4{0.f, 0.f, 0.f, 0.f};
    bf16x8 At[4][2], B0[2][2], B1[2][2];
    STAGE(SB(0, 0), Bt, bcol, 0); STAGE(SA(0, 0), A, brow, 0);
    STAGE(SB(0, 1), Bt, bcol + HALF, 0); STAGE(SA(0, 1), A, brow + HALF, 0);
    if (wr == 1) BAR;
    WAIT_V(4); BAR;
    STAGE(SB(1, 0), Bt, bcol, 1); STAGE(SA(1, 0), A, brow, 1); STAGE(SB(1, 1), Bt, bcol + HALF, 1);
    WAIT_V(6); BAR;
    for (int t = 0; t < ntu - 2; t += 2) {
      LDB(B0, 0, 0); SCHED; LDA(At, 0, 0); STAGE(SA(1, 1), A, brow + HALF, t + 1);
      WAIT_L(8); BAR; WAIT_L(0); MMA(0, 0, At, B0); BAR; SCHED;
      LDB(B1, 0, 1); STAGE(SB(0, 0), Bt, bcol, t + 2);
      BAR; WAIT_L(0); MMA(0, 1, At, B1); BAR;
      LDA(At, 0, 1); STAGE(SA(0, 0), A, brow, t + 2);
      BAR; WAIT_L(0); MMA(1, 0, At, B0); BAR; SCHED;
      STAGE(SB(0, 1), Bt, bcol + HALF, t + 2);
      WAIT_V(6); BAR; MMA(1, 1, At, B1); BAR;
      LDB(B0, 1, 0); SCHED; LDA(At, 1, 0); STAGE(SA(0, 1), A, brow + HALF, t + 2);
      WAIT_L(8); BAR; WAIT_L(0); MMA(0, 0, At, B0); BAR; SCHED;
      LDB(B1, 1, 1); STAGE(SB(1, 0), Bt, bcol, t + 3);
      BAR; WAIT_L(0); MMA(0, 1, At, B1); BAR;
      LDA(At, 1, 1); STAGE(SA(1, 0), A, brow, t + 3);
      BAR; WAIT_L(0); MMA(1, 0, At, B0); BAR; SCHED;
      STAGE(SB(1, 1), Bt, bcol + HALF, t + 3);
      WAIT_V(6); BAR; MMA(1, 1, At, B1); BAR;
    }
    { LDB(B0, 0, 0); LDA(At, 0, 0); STAGE(SA(1, 1), A, brow + HALF, ntu - 1);
      BAR; WAIT_L(0); MMA(0, 0, At, B0); BAR;
      LDB(B1, 0, 1); BAR; WAIT_L(0); MMA(0, 1, At, B1); BAR;
      LDA(At, 0, 1); WAIT_V(4); BAR; WAIT_L(0); MMA(1, 0, At, B0); MMA(1, 1, At, B1); BAR; }
    { LDB(B0, 1, 0); LDA(At, 1, 0); WAIT_V(2); BAR; WAIT_L(0); MMA(0, 0, At, B0); BAR;
      LDB(B1, 1, 1); WAIT_V(0); BAR; WAIT_L(0); MMA(0, 1, At, B1); BAR;
      LDA(At, 1, 1); BAR; WAIT_L(0); MMA(1, 0, At, B0); MMA(1, 1, At, B1); BAR; }
    if (wr == 0) BAR;
    const int mr = (brow < NLAT) ? (brow >> 11) : 8;
    int t2 = threadIdx.x; asm volatile("" : "+v"(t2));
    const int fr_e = t2 & 15, fq_e = (t2 >> 4) & 3;
#define EPI_LOOP(BODY) _Pragma("unroll") for (int ai = 0; ai < 2; ++ai) _Pragma("unroll") for (int m = 0; m < 4; ++m) { \
      const size_t row = (size_t)(brow + ai * HALF + wr * 64 + m * 16 + fr_e); BODY }
    if (EPI == 0) {
      EPI_LOOP(
        _Pragma("unroll") for (int bj = 0; bj < 2; ++bj) _Pragma("unroll") for (int n = 0; n < 2; ++n) { const f32x4 v = acc[ai][bj][m][n];
          *(float4*)(ea.outf + row * ea.ldo + bcol + bj * HALF + wc * 32 + n * 16 + fq_e * 4) = make_float4(v[0], v[1], v[2], v[3]); } )
    } else if (EPI == 1) {
      EPI_LOOP(
        _Pragma("unroll") for (int n = 0; n < 2; ++n) { const f32x4 gt = acc[ai][0][m][n]; const f32x4 up = acc[ai][1][m][n]; s16x4 o;
          _Pragma("unroll") for (int j = 0; j < 4; ++j) o[j] = (short)f2bf(gt[j] * __builtin_amdgcn_rcpf(1.f + __expf(-gt[j])) * up[j]);
          *(s16x4*)(ea.outb + row * ea.ldo + pn * HALF + wc * 32 + n * 16 + fq_e * 4) = o; } )
    } else if (EPI == 2 && split >= 0) {
      EPI_LOOP(
        _Pragma("unroll") for (int bj = 0; bj < 2; ++bj) _Pragma("unroll") for (int n = 0; n < 2; ++n) { const f32x4 v = acc[ai][bj][m][n];
          *(float4*)(ea.part + ((size_t)split * NCTX + (row - NLAT)) * 1024 + bcol + bj * HALF + wc * 32 + n * 16 + fq_e * 4) = make_float4(v[0], v[1], v[2], v[3]); } )
    } else if (EPI == 2) {
      EPI_LOOP(
        _Pragma("unroll") for (int bj = 0; bj < 2; ++bj) _Pragma("unroll") for (int n = 0; n < 2; ++n) { const int col = bcol + bj * HALF + wc * 32 + n * 16 + fq_e * 4;
          const f32x4 v = acc[ai][bj][m][n]; const float4 g = *(const float4*)(ea.aux + mr * 9216 + col);
          float4* xp = (float4*)(ea.outf + row * 1024 + col); float4 x = *(const float4*)(ea.xin + row * 1024 + col);
          x.x += ea.coef * g.x * v[0]; x.y += ea.coef * g.y * v[1]; x.z += ea.coef * g.z * v[2]; x.w += ea.coef * g.w * v[3]; *xp = x; } )
    } else {
      EPI_LOOP(
        _Pragma("unroll") for (int n = 0; n < 2; ++n) { const int cl = pn * HALF + wc * 32 + n * 16 + fq_e * 4;
          const f32x4 av = acc[ai][0][m][n]; const f32x4 bv = acc[ai][1][m][n];
          const float4 ba = *(const float4*)(ea.aux + cl); const float4 bb = *(const float4*)(ea.aux + 256 + cl); s16x4 o;
          o[0] = (short)f2bf((av[0] + ba.x) * __builtin_amdgcn_rcpf(1.f + __expf(-(bv[0] + bb.x)))); o[1] = (short)f2bf((av[1] + ba.y) * __builtin_amdgcn_rcpf(1.f + __expf(-(bv[1] + bb.y))));
          o[2] = (short)f2bf((av[2] + ba.z) * __builtin_amdgcn_rcpf(1.f + __expf(-(bv[2] + bb.z)))); o[3] = (short)f2bf((av[3] + ba.w) * __builtin_amdgcn_rcpf(1.f + __expf(-(bv[3] + bb.w))));
          *(s16x4*)(ea.outb + row * ea.ldo + ea.coloff + cl) = o; } )
    }
#undef EPI_LOOP
    __syncthreads();
  }
#undef SA
#undef SB
}

DEVI int seq_row(int b, int dir, int i) {
  if (i < 256) { const int s = dir ? 255 - i : i; return NLAT + b * 256 + s; }
  const int j = i - 256; const int t = dir ? 2047 - j : j; return b * 2048 + t;
}

DEVI int mirror_blk(int nf) { return nf < 4 ? 3 - nf : 39 - nf; }

DEVI bf16x8 pk8(float a0, float a1, float a2, float a3, float b0, float b1, float b2, float b3) {
  bf16x8 r; r[0] = (short)f2bf(a0); r[1] = (short)f2bf(a1); r[2] = (short)f2bf(a2); r[3] = (short)f2bf(a3);
  r[4] = (short)f2bf(b0); r[5] = (short)f2bf(b1); r[6] = (short)f2bf(b2); r[7] = (short)f2bf(b3); return r;
}
template <int C> DEVI float dppz(float v) { return __int_as_float(__builtin_amdgcn_update_dpp(0, __float_as_int(v), C, 0xf, 0xf, true)); }
DEVI float bperm(float v, int srclane) { return __int_as_float(__builtin_amdgcn_ds_bpermute(srclane << 2, __float_as_int(v))); }
#define MFMA16(a, b, c) __builtin_amdgcn_mfma_f32_16x16x32_bf16((a), (b), (c), 0, 0, 0)

template <int MODE>
DEVI void hgrn_wave_block(const Params& p, const float* __restrict__ P, float* KS, const int l, const int b, const int h, const int dir, const int n, const int lane,
                          f32x4 (&S)[4][4], float (&dsum)[4][4]) {
  const int fr = lane & 15, fq = lane >> 4;
  const int zb = (dir ? 768 : 512) + h * 64 + 4 * fq;
  float* OF = (float*)(p.ws + OFF_YS + (8u << 20));
  float lbv[4][4];
#pragma unroll
  for (int m = 0; m < 4; ++m) { const float4 t = *(const float4*)((const float*)(p.ws + OFF_LB) + (l * 2 + dir) * 256 + h * 64 + 16 * m + 4 * fq); lbv[m][0] = t.x; lbv[m][1] = t.y; lbv[m][2] = t.z; lbv[m][3] = t.w; }
#pragma unroll 1
  for (int c4 = 0; c4 < 4; ++c4) {
    const int i0 = 64 * n + 16 * c4;
    const size_t rt = (size_t)seq_row(b, dir, i0 + fr);
    float z[4][4], q[4][4], vv[4][4];
#pragma unroll
    for (int m = 0; m < 4; ++m) {
      const float4 t = *(const float4*)(P + rt * DIN + zb + 16 * m); z[m][0] = t.x; z[m][1] = t.y; z[m][2] = t.z; z[m][3] = t.w;
      if (MODE != 0) { const float4 u = *(const float4*)(P + rt * DIN + h * 64 + 16 * m + 4 * fq); q[m][0] = u.x; q[m][1] = u.y; q[m][2] = u.z; q[m][3] = u.w; }
    }
#pragma unroll
    for (int j = 0; j < 4; ++j) {
      const size_t rs = (size_t)seq_row(b, dir, i0 + 4 * fq + j);
#pragma unroll
      for (int nt = 0; nt < 4; ++nt) vv[nt][j] = P[rs * DIN + 256 + h * 64 + 16 * nt + fr];
    }
    float Qh[4][4], Kh[4][4], dec[4][4];
#pragma unroll
    for (int m = 0; m < 4; ++m) {
      float ku[4];
#pragma unroll
      for (int j = 0; j < 4; ++j) {
        const float zc = fminf(fmaxf(z[m][j], -80.f), 80.f);
        const float e1 = __expf(-zc), sig = __builtin_amdgcn_rcpf(1.f + e1);
        const float lb = lbv[m][j];
        const float lf = __logf(lb + (1.f - lb) * sig);
        const float kk = (1.f - lb) * e1 * sig;
        float B = lf;
        B += dppz<0x111>(B); B += dppz<0x112>(B); B += dppz<0x114>(B); B += dppz<0x118>(B);
        const float bs = bperm(B, lane | 15);
        const float Bc = fmaxf(B, -80.f);
        const float eB = __expf(Bc);
        Kh[m][j] = kk * __builtin_amdgcn_rcpf(eB);
        if (MODE != 0) Qh[m][j] = q[m][j] * __builtin_amdgcn_rcpf(1.f + __expf(-q[m][j])) * eB;
        dec[m][j] = __expf(bs);
        ku[j] = Kh[m][j] * dec[m][j];
        if (MODE == 0) dsum[m][j] += bs;
      }
      *(float4*)(KS + fr * 68 + 16 * m + 4 * fq) = make_float4(ku[0], ku[1], ku[2], ku[3]);
    }
    __builtin_amdgcn_fence(__ATOMIC_ACQ_REL, "wavefront"); __builtin_amdgcn_wave_barrier();
    bf16x8 KuTf[4], Vf[4];
#pragma unroll
    for (int mt = 0; mt < 4; ++mt) {
      const float a0 = KS[(4 * fq + 0) * 68 + 16 * mt + fr], a1 = KS[(4 * fq + 1) * 68 + 16 * mt + fr], a2 = KS[(4 * fq + 2) * 68 + 16 * mt + fr], a3 = KS[(4 * fq + 3) * 68 + 16 * mt + fr];
      KuTf[mt] = pk8(a0, a1, a2, a3, 0.f, 0.f, 0.f, 0.f);
      Vf[mt] = pk8(vv[mt][0], vv[mt][1], vv[mt][2], vv[mt][3], 0.f, 0.f, 0.f, 0.f);
    }
    __builtin_amdgcn_fence(__ATOMIC_ACQ_REL, "wavefront"); __builtin_amdgcn_wave_barrier();
    if (MODE != 0) {
      bf16x8 Qf[2], Kf[2];
#pragma unroll
      for (int ks = 0; ks < 2; ++ks) {
        Qf[ks] = pk8(Qh[2 * ks][0], Qh[2 * ks][1], Qh[2 * ks][2], Qh[2 * ks][3], Qh[2 * ks + 1][0], Qh[2 * ks + 1][1], Qh[2 * ks + 1][2], Qh[2 * ks + 1][3]);
        Kf[ks] = pk8(Kh[2 * ks][0], Kh[2 * ks][1], Kh[2 * ks][2], Kh[2 * ks][3], Kh[2 * ks + 1][0], Kh[2 * ks + 1][1], Kh[2 * ks + 1][2], Kh[2 * ks + 1][3]);
      }
      f32x4 sc = f32x4{0.f, 0.f, 0.f, 0.f};
      sc = MFMA16(Kf[0], Qf[0], sc); sc = MFMA16(Kf[1], Qf[1], sc);
      const bf16x8 Pf = pk8((4 * fq + 0 <= fr) ? sc[0] : 0.f, (4 * fq + 1 <= fr) ? sc[1] : 0.f, (4 * fq + 2 <= fr) ? sc[2] : 0.f, (4 * fq + 3 <= fr) ? sc[3] : 0.f, 0.f, 0.f, 0.f, 0.f);
      f32x4 O[4];
#pragma unroll
      for (int mt = 0; mt < 4; ++mt) {
        f32x4 o = f32x4{0.f, 0.f, 0.f, 0.f};
#pragma unroll
        for (int ks = 0; ks < 2; ++ks) {
          const bf16x8 Sf = pk8(S[2 * ks][mt][0], S[2 * ks][mt][1], S[2 * ks][mt][2], S[2 * ks][mt][3], S[2 * ks + 1][mt][0], S[2 * ks + 1][mt][1], S[2 * ks + 1][mt][2], S[2 * ks + 1][mt][3]);
          o = MFMA16(Sf, Qf[ks], o);
        }
        O[mt] = MFMA16(Vf[mt], Pf, o);
      }
      if (MODE == 1) {
#pragma unroll
        for (int mt = 0; mt < 4; ++mt) *(float4*)(OF + rt * 256 + h * 64 + 16 * mt + 4 * fq) = make_float4(O[mt][0], O[mt][1], O[mt][2], O[mt][3]);
      } else {
        float ss = 0.f;
#pragma unroll
        for (int mt = 0; mt < 4; ++mt) { const float4 of = *(const float4*)(OF + rt * 256 + h * 64 + 16 * mt + 4 * fq);
          O[mt][0] += of.x; O[mt][1] += of.y; O[mt][2] += of.z; O[mt][3] += of.w;
          ss += O[mt][0] * O[mt][0] + O[mt][1] * O[mt][1] + O[mt][2] * O[mt][2] + O[mt][3] * O[mt][3]; }
        ss += bperm(ss, lane ^ 16); ss += bperm(ss, lane ^ 32);
        const float rstd = rsqrtf(ss * (1.f / 64.f) + 1e-6f);
        bf16_t* MIX = (bf16_t*)(p.ws + OFF_MIX);
#pragma unroll
        for (int mt = 0; mt < 4; ++mt) {
          const float4 gg = *(const float4*)(P + rt * DIN + 1024 + h * 64 + 16 * mt + 4 * fq);
          const float4 hg = *(const float4*)(p.hnorm_g + l * 256 + h * 64 + 16 * mt + 4 * fq);
          s16x4 o;
          o[0] = (short)f2bf(O[mt][0] * rstd * hg.x * silu_f(gg.x)); o[1] = (short)f2bf(O[mt][1] * rstd * hg.y * silu_f(gg.y));
          o[2] = (short)f2bf(O[mt][2] * rstd * hg.z * silu_f(gg.z)); o[3] = (short)f2bf(O[mt][3] * rstd * hg.w * silu_f(gg.w));
          *(s16x4*)(MIX + rt * 1024 + h * 64 + 16 * mt + 4 * fq) = o;
        }
      }
    }
#pragma unroll
    for (int mtk = 0; mtk < 4; ++mtk)
#pragma unroll
      for (int ntv = 0; ntv < 4; ++ntv) {
        f32x4 s = S[mtk][ntv];
        s[0] *= dec[mtk][0]; s[1] *= dec[mtk][1]; s[2] *= dec[mtk][2]; s[3] *= dec[mtk][3];
        S[mtk][ntv] = MFMA16(KuTf[mtk], Vf[ntv], s);
      }
  }
}

DEVI void hgrn_load_S(const float* __restrict__ HU, const int lane_off, f32x4 (&S)[4][4]) {
#pragma unroll
  for (int mtk = 0; mtk < 4; ++mtk) {
    int off = lane_off + mtk * 1024; asm volatile("" : "+v"(off));
    const float* pm = HU + off;
#pragma unroll
    for (int ntv = 0; ntv < 4; ++ntv)
#pragma unroll
      for (int j = 0; j < 4; ++j) S[mtk][ntv][j] = pm[j * 64 + 16 * ntv];
  }
}
DEVI void hgrn_store_S(float* __restrict__ HU, const int lane_off, const f32x4 (&S)[4][4]) {
#pragma unroll
  for (int mtk = 0; mtk < 4; ++mtk) {
    int off = lane_off + mtk * 1024; asm volatile("" : "+v"(off));
    float* pm = HU + off;
#pragma unroll
    for (int ntv = 0; ntv < 4; ++ntv)
#pragma unroll
      for (int j = 0; j < 4; ++j) pm[j * 64 + 16 * ntv] = S[mtk][ntv][j];
  }
}
DEVI void hgrn_local_task(const Params& p, int l, int task, int lane, float* KS) {
  const int seq = task / 36, n = task % 36, b = seq >> 3, h = (seq >> 1) & 3, dir = seq & 1, fr = lane & 15, fq = lane >> 4;
  f32x4 S[4][4]; float dsum[4][4];
#pragma unroll
  for (int a = 0; a < 4; ++a)
#pragma unroll
    for (int c = 0; c < 4; ++c) { S[a][c] = f32x4{0.f, 0.f, 0.f, 0.f}; dsum[a][c] = 0.f; }
  hgrn_wave_block<0>(p, (const float*)(p.ws + OFF_P), KS, l, b, h, dir, n, lane, S, dsum);
  hgrn_store_S((float*)(p.ws + OFF_OA) + (size_t)(seq * 36 + n) * 4096, 4 * fq * 64 + fr, S);
  if (fr == 0) {
    float* HD = (float*)(p.ws + OFF_YS) + (seq * 36 + n) * 64;
#pragma unroll
    for (int m = 0; m < 4; ++m)
#pragma unroll
      for (int j = 0; j < 4; ++j) HD[16 * m + 4 * fq + j] = __expf(dsum[m][j]);
  }
}
DEVI void hgrn_out_task(const Params& p, int l, int task, int lane, float* KS) {
  const int b = task / 144, h = (task / 36) & 3, nf = task % 36, fr = lane & 15, fq = lane >> 4;
  if (l == 3 && nf < 4) return;
  const float* P = (const float*)(p.ws + OFF_P);
  f32x4 S[4][4]; float dsum[4][4];
  hgrn_load_S((const float*)(p.ws + OFF_OA) + (size_t)(((b * 4 + h) * 2 + 0) * 36 + nf) * 4096, 4 * fq * 64 + fr, S);
  hgrn_wave_block<1>(p, P, KS, l, b, h, 0, nf, lane, S, dsum);
  asm volatile("s_waitcnt vmcnt(0)" ::: "memory");
  __builtin_amdgcn_fence(__ATOMIC_ACQUIRE, "agent");
  hgrn_load_S((const float*)(p.ws + OFF_OA) + (size_t)(((b * 4 + h) * 2 + 1) * 36 + mirror_blk(nf)) * 4096, 4 * fq * 64 + fr, S);
  hgrn_wave_block<2>(p, P, KS, l, b, h, 1, mirror_blk(nf), lane, S, dsum);
}

__device__ void hgrn_scan_item(const Params& p, int j) {
  int tid = threadIdx.x; asm volatile("" : "+v"(tid));
  const int seq = j >> 3, el = (j & 7) * 512 + tid, k = el >> 6;
  float* HU = (float*)(p.ws + OFF_OA) + (size_t)seq * 36 * 4096 + el;
  const float* HD = (const float*)(p.ws + OFF_YS) + seq * 36 * 64 + k;
  float s = 0.f;
#pragma unroll 6
  for (int n = 0; n < 36; ++n) { const float u = HU[(size_t)n * 4096]; const float d = HD[n * 64]; HU[(size_t)n * 4096] = s; s = d * s + u; }
}
DEVI int crow(int i, int h) { return (i & 3) + 8 * (i >> 2) + 4 * h; }
DEVI void split8(const float4 a, const float4 b, const float sgn, bf16x8& hi, bf16x8& lo) {
  const float v[8] = {a.x, a.y, a.z, a.w, b.x, b.y, b.z, b.w};
#pragma unroll
  for (int j = 0; j < 8; ++j) { const float x = sgn * v[j]; const unsigned short hh = f2bf(x); hi[j] = (short)hh; lo[j] = (short)f2bf(x - __uint_as_float((unsigned)hh << 16)); }
}
DEVI int sphys(int t, int col) { return t * 128 + ((((col >> 2) ^ (t & 7)) << 2) | (col & 3)); }

template <int MODE>
DEVI void s5_wave_dir(const Params& p, const float* __restrict__ P, float* SB, const int l, const int b, const int g, const int dir, const int n, const int lane, float& hr, float& hi, f32x4 (&Y)[4]) {
  const int e = (l * 2 + dir) * 16 + g;
  const int r = lane & 31, h = lane >> 5, fr = lane & 15, fq = lane >> 4;
  const float ar = ((const float*)(p.ws + OFF_ABAR))[(e * 64 + lane) * 2], ai = ((const float*)(p.ws + OFF_ABAR))[(e * 64 + lane) * 2 + 1];
  bf16x8 bh[4], bl[4];
#pragma unroll
  for (int nt = 0; nt < 4; ++nt) {
    const int n_ = 32 * nt + r, ri = n_ >> 6, pq = n_ & 63;
    const float* bp = (const float*)(p.ws + OFF_BBAR) + ((size_t)((e * 2 + ri) * 64 + pq)) * 16 + 8 * h;
    split8(*(const float4*)bp, *(const float4*)(bp + 4), 1.f, bh[nt], bl[nt]);
  }
  bf16x8 chh[4], chl[4];
  if (MODE == 1) {
#pragma unroll
    for (int ks = 0; ks < 4; ++ks) {
      const float* cp = ((ks < 2) ? p.c_re : p.c_im) + (size_t)e * 1024 + fr * 64 + (ks & 1) * 32 + fq * 8;
      split8(*(const float4*)cp, *(const float4*)(cp + 4), (ks < 2) ? 1.f : -1.f, chh[ks], chl[ks]);
    }
  }
  float4 ur[2][2];
#pragma unroll
  for (int hb = 0; hb < 2; ++hb) { const float* up = P + (size_t)seq_row(b, dir, 64 * n + 32 * hb + r) * DIN + 2048 + g * 16 + 8 * h; ur[hb][0] = *(const float4*)up; ur[hb][1] = *(const float4*)(up + 4); }
#pragma unroll
  for (int hb = 0; hb < 2; ++hb) {
    { bf16x8 uh, ul; split8(ur[hb][0], ur[hb][1], 1.f, uh, ul);
#pragma unroll
      for (int nt = 0; nt < 4; ++nt) {
        f32x16 x;
#pragma unroll
        for (int i = 0; i < 16; ++i) x[i] = 0.f;
        x = __builtin_amdgcn_mfma_f32_32x32x16_bf16(uh, bh[nt], x, 0, 0, 0);
        x = __builtin_amdgcn_mfma_f32_32x32x16_bf16(uh, bl[nt], x, 0, 0, 0);
        x = __builtin_amdgcn_mfma_f32_32x32x16_bf16(ul, bh[nt], x, 0, 0, 0);
#pragma unroll
        for (int i = 0; i < 16; ++i) SB[sphys(crow(i, h), 32 * nt + r)] = x[i];
      } }
    __builtin_amdgcn_fence(__ATOMIC_ACQ_REL, "wavefront"); __builtin_amdgcn_wave_barrier();
#pragma unroll
    for (int tb = 0; tb < 32; tb += 16) {
      float sre[16], sim[16];
#pragma unroll
      for (int t = 0; t < 16; ++t) { sre[t] = SB[sphys(tb + t, lane)]; sim[t] = SB[sphys(tb + t, 64 + lane)]; }
#pragma unroll
      for (int t = 0; t < 16; ++t) {
        const float nr = ar * hr - ai * hi + sre[t], ni = ar * hi + ai * hr + sim[t];
        hr = nr; hi = ni; sre[t] = hr; sim[t] = hi;
      }
      if (MODE == 1) {
#pragma unroll
        for (int t = 0; t < 16; ++t) { SB[sphys(tb + t, lane)] = sre[t]; SB[sphys(tb + t, 64 + lane)] = sim[t]; }
      }
    }
    __builtin_amdgcn_fence(__ATOMIC_ACQ_REL, "wavefront"); __builtin_amdgcn_wave_barrier();
    if (MODE == 1) {
#pragma unroll
      for (int m2 = 0; m2 < 2; ++m2) {
        const int trow = 16 * m2 + (dir ? 15 - fr : fr);
#pragma unroll
        for (int ks = 0; ks < 4; ++ks) {
          const int c0 = ks * 32 + fq * 8;
          bf16x8 ah, al; split8(*(const float4*)(SB + sphys(trow, c0)), *(const float4*)(SB + sphys(trow, c0 + 4)), 1.f, ah, al);
          Y[2 * hb + m2] = __builtin_amdgcn_mfma_f32_16x16x32_bf16(ah, chh[ks], Y[2 * hb + m2], 0, 0, 0);
          Y[2 * hb + m2] = __builtin_amdgcn_mfma_f32_16x16x32_bf16(ah, chl[ks], Y[2 * hb + m2], 0, 0, 0);
          Y[2 * hb + m2] = __builtin_amdgcn_mfma_f32_16x16x32_bf16(al, chh[ks], Y[2 * hb + m2], 0, 0, 0);
        }
      }
      __builtin_amdgcn_fence(__ATOMIC_ACQ_REL, "wavefront"); __builtin_amdgcn_wave_barrier();
    }
  }
}

DEVI void s5_local_task(const Params& p, int l, int t, int lane, float* SB) {
  const int g = t & 15, n = (t >> 4) % 36, bd = (t >> 4) / 36, dir = bd & 1, b = bd >> 1;
  float hr = 0.f, hi = 0.f; f32x4 Y[4];
  s5_wave_dir<0>(p, (const float*)(p.ws + OFF_P), SB, l, b, g, dir, n, lane, hr, hi, Y);
  float2* SE = (float2*)(p.ws + OFF_YS + (1u << 20));
  SE[((size_t)((b * 16 + g) * 2 + dir) * 36 + n) * 64 + lane] = make_float2(hr, hi);
}
DEVI void s5_out_task(const Params& p, int l, int t, int lane, float* SB) {
  const int g = t & 15, nf = (t >> 4) % 36, b = (t >> 4) / 36, fr = lane & 15, fq = lane >> 4;
  if (l == 3 && nf < 4) return;
  const float* P = (const float*)(p.ws + OFF_P);
  f32x4 Y[4];
#pragma unroll
  for (int i = 0; i < 4; ++i) Y[i] = f32x4{0.f, 0.f, 0.f, 0.f};
#pragma unroll 1
  for (int dir = 0; dir < 2; ++dir) {
    const int n = dir ? mirror_blk(nf) : nf;
    const float2 cin = ((const float2*)(p.ws + OFF_YS + (1u << 20)))[((size_t)((b * 16 + g) * 2 + dir) * 36 + n) * 64 + lane];
    float hr = cin.x, hi = cin.y;
    s5_wave_dir<1>(p, P, SB, l, b, g, dir, n, lane, hr, hi, Y);
    { const f32x4 t0 = Y[0], t1 = Y[1]; Y[0] = Y[3]; Y[1] = Y[2]; Y[2] = t1; Y[3] = t0; }
  }
  const float dv = p.s5_d[l * 256 + g * 16 + fr];
  bf16_t* GA = (bf16_t*)(p.ws + OFF_GA);
#pragma unroll
  for (int mt = 0; mt < 4; ++mt)
#pragma unroll
    for (int j = 0; j < 4; ++j) {
      const int tl = 16 * mt + fq * 4 + j;
      const size_t row = (size_t)seq_row(b, 0, nf * 64 + tl);
      const float u = P[row * DIN + 2048 + g * 16 + fr];
      const float t2 = Y[mt][j] + dv * u;
      GA[row * 256 + g * 16 + fr] = f2bf(t2 * __builtin_amdgcn_rcpf(1.f + __expf(-1.5957691216057308f * (t2 + 0.044715f * t2 * t2 * t2))));
    }
}

__device__ void attn_item(const Params& p, int l, int a) {
  extern __shared__ __attribute__((aligned(16))) unsigned char lds_raw[];
  bf16_t* Ks = (bf16_t*)lds_raw;
  bf16_t* Vt = (bf16_t*)(lds_raw + 128 * 72 * 2);
  const float* P = (const float*)(p.ws + OFF_P);
  const float* RC = (const float*)(p.ws + OFF_ROPE); const float* RS = RC + 1024;
  bf16_t* MIX = (bf16_t*)(p.ws + OFF_MIX);
  int tid = threadIdx.x; asm volatile("" : "+v"(tid));
  const int lane = tid & 63, w = tid >> 6, r = lane & 31, h = lane >> 5;
  const bool lat = a < 512;
  int b, hk, n = 0, t0, qrow0;
  if (lat) { b = a >> 6; const int rem = a & 63; n = rem >> 2; hk = (rem >> 1) & 1; t0 = n * 128 + (rem & 1) * 64; qrow0 = b * 2048 + t0; }
  else { const int c = a - 512; b = c >> 3; hk = (c >> 2) & 1; t0 = (c & 3) * 64; qrow0 = NLAT + b * 256 + t0; }
  const int g = w >> 1, qsub = w & 1, tq = t0 + qsub * 32 + r, qrow = qrow0 + qsub * 32 + r, hq = hk * 4 + g;
  bf16x8 qf[4];
  { const float* qp = P + (size_t)qrow * DIN + 1280 + hq * 64;
#pragma unroll
    for (int a2 = 0; a2 < 2; ++a2) {
      float x1[8], x2[8];
      { const float4 u0 = *(const float4*)(qp + a2 * 32 + 8 * h), u1 = *(const float4*)(qp + a2 * 32 + 8 * h + 4);
        const float4 w0 = *(const float4*)(qp + a2 * 32 + 16 + 8 * h), w1 = *(const float4*)(qp + a2 * 32 + 16 + 8 * h + 4);
        x1[0] = u0.x; x1[1] = u0.y; x1[2] = u0.z; x1[3] = u0.w; x1[4] = u1.x; x1[5] = u1.y; x1[6] = u1.z; x1[7] = u1.w;
        x2[0] = w0.x; x2[1] = w0.y; x2[2] = w0.z; x2[3] = w0.w; x2[4] = w1.x; x2[5] = w1.y; x2[6] = w1.z; x2[7] = w1.w; }
      const int pos = (a2 == 0) ? (tq >> 6) : (tq & 63);
      float cs[8], sn[8];
      { const float4 c0 = *(const float4*)(RC + pos * 16 + 8 * h), c1 = *(const float4*)(RC + pos * 16 + 8 * h + 4);
        const float4 s0 = *(const float4*)(RS + pos * 16 + 8 * h), s1 = *(const float4*)(RS + pos * 16 + 8 * h + 4);
        cs[0] = c0.x; cs[1] = c0.y; cs[2] = c0.z; cs[3] = c0.w; cs[4] = c1.x; cs[5] = c1.y; cs[6] = c1.z; cs[7] = c1.w;
        sn[0] = s0.x; sn[1] = s0.y; sn[2] = s0.z; sn[3] = s0.w; sn[4] = s1.x; sn[5] = s1.y; sn[6] = s1.z; sn[7] = s1.w; }
#pragma unroll
      for (int j = 0; j < 8; ++j) {
        const float c = lat ? cs[j] : 1.f, sv = lat ? sn[j] : 0.f;
        const float o1 = x1[j] * c - x2[j] * sv, o2 = x2[j] * c + x1[j] * sv;
        qf[2 * a2][j] = (short)f2bf(o1 * 0.18033688f); qf[2 * a2 + 1][j] = (short)f2bf(o2 * 0.18033688f);
      }
    } }
  const float sinkv = p.sink[l * 8 + hq] * 1.44269504f;
  float mrun = sinkv, lsum = 0.5f;
  f32x16 O0, O1;
#pragma unroll
  for (int i = 0; i < 16; ++i) { O0[i] = 0.f; O1[i] = 0.f; }
  for (int blk = 0; blk < 5; ++blk) {
    bool kl; int kb;
    if (blk < 3) { if (!lat) continue; kb = n - 1 + blk; if (kb < 0 || kb > 15) continue; kl = true; }
    else { kl = false; kb = blk - 3; }
    __syncthreads();
    {
      const int key = tid >> 2, qd = tid & 3, a2 = qd >> 1, i0 = (qd & 1) * 8;
      const int s = kb * 128 + key;
      const size_t krow = kl ? (size_t)(b * 2048 + s) : (size_t)(NLAT + b * 256 + s);
      const float* kp = P + krow * DIN + 1792 + hk * 64;
      float x1[8], x2[8];
      { const float4 u0 = *(const float4*)(kp + a2 * 32 + i0), u1 = *(const float4*)(kp + a2 * 32 + i0 + 4);
        const float4 w0 = *(const float4*)(kp + a2 * 32 + 16 + i0), w1 = *(const float4*)(kp + a2 * 32 + 16 + i0 + 4);
        x1[0] = u0.x; x1[1] = u0.y; x1[2] = u0.z; x1[3] = u0.w; x1[4] = u1.x; x1[5] = u1.y; x1[6] = u1.z; x1[7] = u1.w;
        x2[0] = w0.x; x2[1] = w0.y; x2[2] = w0.z; x2[3] = w0.w; x2[4] = w1.x; x2[5] = w1.y; x2[6] = w1.z; x2[7] = w1.w; }
      const int pos = (a2 == 0) ? (s >> 6) : (s & 63);
      float cs[8], sn[8];
      { const float4 c0 = *(const float4*)(RC + pos * 16 + i0), c1 = *(const float4*)(RC + pos * 16 + i0 + 4);
        const float4 s0 = *(const float4*)(RS + pos * 16 + i0), s1 = *(const float4*)(RS + pos * 16 + i0 + 4);
        cs[0] = c0.x; cs[1] = c0.y; cs[2] = c0.z; cs[3] = c0.w; cs[4] = c1.x; cs[5] = c1.y; cs[6] = c1.z; cs[7] = c1.w;
        sn[0] = s0.x; sn[1] = s0.y; sn[2] = s0.z; sn[3] = s0.w; sn[4] = s1.x; sn[5] = s1.y; sn[6] = s1.z; sn[7] = s1.w; }
      bf16x8 o1v, o2v;
#pragma unroll
      for (int j = 0; j < 8; ++j) {
        const float c = kl ? cs[j] : 1.f, sv = kl ? sn[j] : 0.f;
        o1v[j] = (short)f2bf(x1[j] * c - x2[j] * sv); o2v[j] = (short)f2bf(x2[j] * c + x1[j] * sv);
      }
      *(bf16x8*)(Ks + key * 72 + a2 * 32 + i0) = o1v; *(bf16x8*)(Ks + key * 72 + a2 * 32 + 16 + i0) = o2v;
      const float* vp = P + krow * DIN + 1920 + hk * 64 + qd * 16;
#pragma unroll
      for (int q = 0; q < 4; ++q) { const float4 v = *(const float4*)(vp + q * 4);
        Vt[(qd * 16 + q * 4 + 0) * 132 + key] = f2bf(v.x); Vt[(qd * 16 + q * 4 + 1) * 132 + key] = f2bf(v.y);
        Vt[(qd * 16 + q * 4 + 2) * 132 + key] = f2bf(v.z); Vt[(qd * 16 + q * 4 + 3) * 132 + key] = f2bf(v.w); }
    }
    __syncthreads();
#pragma unroll 1
    for (int kt = 0; kt < 4; ++kt) {
      if (kl && ((kb == n - 1 && (t0 & 64) && kt < 2) || (kb == n + 1 && !(t0 & 64) && kt >= 2))) continue;
      f32x16 xs;
#pragma unroll
      for (int i = 0; i < 16; ++i) xs[i] = 0.f;
#pragma unroll
      for (int ds = 0; ds < 4; ++ds) { const bf16x8 kf = *(const bf16x8*)(Ks + (kt * 32 + r) * 72 + ds * 16 + 8 * h); xs = __builtin_amdgcn_mfma_f32_32x32x16_bf16(kf, qf[ds], xs, 0, 0, 0); }
      if (kl && kb != n) {
        const int sb = kb * 128 + kt * 32;
#pragma unroll
        for (int i = 0; i < 16; ++i) { const int d = tq - (sb + crow(i, h)); if (d > 128 || d < -128) xs[i] = -1e9f; }
      }
      float tmax = xs[0];
#pragma unroll
      for (int i = 1; i < 16; ++i) tmax = fmaxf(tmax, xs[i]);
      tmax = fmaxf(tmax, shx(tmax, 32, lane));
      if (__builtin_amdgcn_ballot_w64(tmax - mrun > 8.f) != 0ull) {
        const float mnew = fmaxf(mrun, tmax), alpha = __builtin_amdgcn_exp2f(mrun - mnew);
        mrun = mnew; lsum *= alpha;
#pragma unroll
        for (int i = 0; i < 16; ++i) { O0[i] *= alpha; O1[i] *= alpha; }
      }
      float pv[16], psum = 0.f;
#pragma unroll
      for (int i = 0; i < 16; ++i) { pv[i] = __builtin_amdgcn_exp2f(xs[i] - mrun); psum += pv[i]; }
      lsum += psum;
#pragma unroll
      for (int s2 = 0; s2 < 2; ++s2) {
        bf16x8 ps;
#pragma unroll
        for (int j = 0; j < 8; ++j) ps[j] = (short)f2bf(pv[8 * s2 + j]);
        { const bf16_t* vp = Vt + (r) * 132 + kt * 32 + 16 * s2 + 4 * h; const s16x4 lo = *(const s16x4*)vp, hi2 = *(const s16x4*)(vp + 8);
          const bf16x8 va = __builtin_shufflevector(lo, hi2, 0, 1, 2, 3, 4, 5, 6, 7); O0 = __builtin_amdgcn_mfma_f32_32x32x16_bf16(va, ps, O0, 0, 0, 0); }
        { const bf16_t* vp = Vt + (32 + r) * 132 + kt * 32 + 16 * s2 + 4 * h; const s16x4 lo = *(const s16x4*)vp, hi2 = *(const s16x4*)(vp + 8);
          const bf16x8 va = __builtin_shufflevector(lo, hi2, 0, 1, 2, 3, 4, 5, 6, 7); O1 = __builtin_amdgcn_mfma_f32_32x32x16_bf16(va, ps, O1, 0, 0, 0); }
      }
    }
  }
  const float inv = 1.f / (lsum + shx(lsum, 32, lane));
  bf16_t* op = MIX + (size_t)qrow * 1024 + 256 + hq * 64;
#pragma unroll
  for (int gq = 0; gq < 4; ++gq) {
    s16x4 o0, o1;
#pragma unroll
    for (int j = 0; j < 4; ++j) { o0[j] = (short)f2bf(O0[gq * 4 + j] * inv); o1[j] = (short)f2bf(O1[gq * 4 + j] * inv); }
    *(s16x4*)(op + 8 * gq + 4 * h) = o0; *(s16x4*)(op + 32 + 8 * gq + 4 * h) = o1;
  }
  __syncthreads();
}

#define QUEUE_LOOP(CNT, NITEMS, BODY) do { \
    extern __shared__ __attribute__((aligned(16))) unsigned char lds_raw[]; \
    int* slot_ = (int*)(lds_raw + 131072); int* cnt_ = (CNT); const int nit_ = (NITEMS); \
    __syncthreads(); if (threadIdx.x == 0) *slot_ = atomicAdd(cnt_, 1); __syncthreads(); \
    int it = *slot_; \
    while (it < nit_) { \
      int nxt_ = 0; if (threadIdx.x == 0) nxt_ = atomicAdd(cnt_, 1); \
      BODY \
      if (threadIdx.x == 0) *slot_ = nxt_; __syncthreads(); it = *slot_; __syncthreads(); \
    } } while (0)

__device__ void s5_carry_item(const Params& p, int l, int j) {
  int tid = threadIdx.x; asm volatile("" : "+v"(tid));
  const int lane = tid & 63, q = j * 8 + (tid >> 6), dir = q & 1, g = (q >> 1) & 15;
  const int e = (l * 2 + dir) * 16 + g;
  float pr = ((const float*)(p.ws + OFF_ABAR))[(e * 64 + lane) * 2], pi = ((const float*)(p.ws + OFF_ABAR))[(e * 64 + lane) * 2 + 1];
#pragma unroll
  for (int s = 0; s < 6; ++s) { const float t = pr * pr - pi * pi; pi = 2.f * pr * pi; pr = t; }
  float2* SE = (float2*)(p.ws + OFF_YS + (1u << 20)) + (size_t)q * 36 * 64 + lane;
  float hr = 0.f, hi = 0.f;
#pragma unroll 6
  for (int m = 0; m < 36; ++m) { const float2 ev = SE[m * 64]; SE[m * 64] = make_float2(hr, hi); const float t = pr * hr - pi * hi + ev.x; hi = pr * hi + pi * hr + ev.y; hr = t; }
}
__device__ void phase_MA(const Params& p, const Grp gr, int l) {
  extern __shared__ __attribute__((aligned(16))) unsigned char lds_raw[];
  int tid = threadIdx.x; asm volatile("" : "+v"(tid));
  const int lane = tid & 63, w = __builtin_amdgcn_readfirstlane(tid >> 6);
  const int NS = 8 * gr.nloc, s = w * gr.nloc + gr.rank;
  float* LW = (float*)lds_raw + w * 4096;
  const int nbg = (8 - gr.gi + gr.nx - 1) / gr.nx;
  if (s + NS < nbg * 288) __builtin_amdgcn_s_setprio(2);
#pragma unroll 1
  for (int v = s; v < nbg * 288; v += NS) hgrn_local_task(p, l, 288 * (gr.gi + (v / 288) * gr.nx) + v % 288, lane, LW);
#pragma unroll 1
  for (int v = NS - 1 - s; v < nbg * 1152; v += NS) s5_local_task(p, l, 1152 * (gr.gi + (v / 1152) * gr.nx) + v % 1152, lane, LW);
  __builtin_amdgcn_s_setprio(0);
}
__device__ void phase_MB(const Params& p, const Grp gr, int l) {
  const int nctx = (l < 3) ? 8 : 0;
  for (int b = gr.gi; b < 8; b += gr.nx) {
    QUEUE_LOOP((int*)(p.ws + OFF_CNT) + l * 8 + b, 64 + nctx + 64 + 4,
      if (it < 64) attn_item(p, l, b * 64 + it); else if (it < 64 + nctx) attn_item(p, l, 512 + b * 8 + (it - 64));
      else if (it < 128 + nctx) { hgrn_scan_item(p, b * 64 + (it - 64 - nctx)); __syncthreads(); } else { s5_carry_item(p, l, b * 4 + (it - 128 - nctx)); __syncthreads(); } );
  }
}
__device__ void phase_MC(const Params& p, const Grp gr, int l) {
  extern __shared__ __attribute__((aligned(16))) unsigned char lds_raw[];
  int tid = threadIdx.x; asm volatile("" : "+v"(tid));
  const int lane = tid & 63, w = __builtin_amdgcn_readfirstlane(tid >> 6);
  const int NS = 8 * gr.nloc, s = w * gr.nloc + gr.rank;
  float* LW = (float*)lds_raw + w * 4096;
  const int nbg = (8 - gr.gi + gr.nx - 1) / gr.nx;
  if (s < nbg * 144) __builtin_amdgcn_s_setprio(2);
#pragma unroll 1
  for (int v = s; v < nbg * 144; v += NS) hgrn_out_task(p, l, 144 * (gr.gi + (v / 144) * gr.nx) + v % 144, lane, LW);
#pragma unroll 1
  for (int v = NS - 1 - s; v < nbg * 576; v += NS) s5_out_task(p, l, 576 * (gr.gi + (v / 576) * gr.nx) + v % 576, lane, LW);
  __builtin_amdgcn_s_setprio(0);
}

#define XB_TMO      128
#define XB_XCNT(j)  (256  + 64 * (j))
#define XB_XSUB(j)  (1280 + 64 * (j))
#define XB_XGEN(j)  (2304 + 64 * (j))
#define XB_TOP      3328
#define XB_TOPGEN   3392
#define XB_LSUB(j)  (3456 + 64 * (j))
#define XB_LGEN(j)  (4480 + 64 * (j))
#define XCD_BAR_WORDS 5504
#define XB_SPIN_CAP (1u << 22)
#define LAS __attribute__((address_space(3)))
DEVI unsigned xb_ld(unsigned* p)              { return __hip_atomic_load(p, __ATOMIC_RELAXED, __HIP_MEMORY_SCOPE_AGENT); }
DEVI unsigned xb_add(unsigned* p, unsigned v) { return __hip_atomic_fetch_add(p, v, __ATOMIC_RELAXED, __HIP_MEMORY_SCOPE_AGENT); }
DEVI unsigned xb_xcc_id() { return (unsigned)__builtin_amdgcn_s_getreg((3 << 11) | 20) & 0xFu; }
#define XB_SPIN(cond, bar) do { unsigned _sp = 0; while (cond) { __builtin_amdgcn_s_sleep(1); \
    if ((++_sp & 255u) == 0u) { if (xb_ld(&(bar)[XB_TMO])) break; if (_sp > XB_SPIN_CAP) { atomicAdd(&(bar)[XB_TMO], 1u); break; } } } } while (0)
struct XcdBarrier { unsigned* bar; unsigned x; volatile LAS unsigned* st; };
DEVI XcdBarrier xcd_barrier_post(unsigned* bar, volatile LAS unsigned* st) {
  XcdBarrier b; b.bar = bar; b.x = xb_xcc_id(); b.st = st;
  if (threadIdx.x == 0) st[3] = xb_add(&bar[XB_XCNT(b.x)], 1u);
  return b;
}
DEVI void xcd_barrier_complete(unsigned* bar, unsigned x, unsigned& nloc, unsigned& nx) {
  const unsigned G = gridDim.x * gridDim.y * gridDim.z;
  unsigned sum, cnt, mine, sp = 0u;
  for (;;) {
    sum = 0u; cnt = 0u; mine = 0u;
#pragma unroll
    for (unsigned j = 0; j < 16; ++j) { const unsigned c = xb_ld(&bar[XB_XCNT(j)]); sum += c; cnt += (c > 0u) ? 1u : 0u; mine = (j == x) ? c : mine; }
    if (sum == G) break;
    __builtin_amdgcn_s_sleep(1);
    if ((++sp & 255u) == 0u) { if (xb_ld(&bar[XB_TMO])) break; if (sp > XB_SPIN_CAP) { atomicAdd(&bar[XB_TMO], 1u); break; } }
  }
  nloc = mine > 0u ? mine : 1u; nx = cnt > 0u ? cnt : 1u;
}
DEVI void xcd_barrier(const XcdBarrier& b) {
  asm volatile("s_waitcnt vmcnt(0)" ::: "memory");
  __syncthreads();
  if (threadIdx.x == 0) {
    unsigned* bar = b.bar;
    __builtin_amdgcn_s_waitcnt(0);
    unsigned nloc = b.st[0], nx = b.st[1];
    if (nloc == 0u) { xcd_barrier_complete(bar, b.x, nloc, nx); b.st[0] = nloc; b.st[1] = nx; }
    const unsigned old = xb_add(&bar[XB_XSUB(b.x)], 1u);
    const unsigned gen = old / nloc;
    if (old + 1u == (gen + 1u) * nloc) {
      __builtin_amdgcn_fence(__ATOMIC_RELEASE, "agent");
      asm volatile("s_waitcnt vmcnt(0)" ::: "memory");
      const unsigned og = xb_add(&bar[XB_TOP], 1u);
      const unsigned tg = og / nx;
      if (og + 1u == (tg + 1u) * nx) xb_add(&bar[XB_TOPGEN], 1u);
      else XB_SPIN(xb_ld(&bar[XB_TOPGEN]) == tg, bar);
      __builtin_amdgcn_fence(__ATOMIC_ACQUIRE, "agent");
      xb_add(&bar[XB_XGEN(b.x)], 1u);
      asm volatile("s_waitcnt vmcnt(0)" ::: "memory");
    } else {
      XB_SPIN(xb_ld(&bar[XB_XGEN(b.x)]) == gen, bar);
      __builtin_amdgcn_fence(__ATOMIC_ACQUIRE, "agent");
      asm volatile("s_waitcnt vmcnt(0)" ::: "memory");
    }
  }
  __syncthreads();
}

DEVI void grp_barrier(const XcdBarrier& b) {
  asm volatile("s_waitcnt vmcnt(0)" ::: "memory");
  __syncthreads();
  if (threadIdx.x == 0) {
    unsigned* bar = b.bar;
    __builtin_amdgcn_s_waitcnt(0);
    const unsigned nloc = b.st[0];
    const unsigned old = xb_add(&bar[XB_LSUB(b.x)], 1u);
    const unsigned gen = old / nloc;
    if (old + 1u == (gen + 1u) * nloc) xb_add(&bar[XB_LGEN(b.x)], 1u);
    else XB_SPIN(xb_ld(&bar[XB_LGEN(b.x)]) == gen, bar);
    __builtin_amdgcn_fence(__ATOMIC_ACQUIRE, "agent");
    asm volatile("s_waitcnt vmcnt(0)" ::: "memory");
  }
  __syncthreads();
}

__global__ void __launch_bounds__(NTHR) mega(Params p) {
  cg::grid_group grid = cg::this_grid();
  phase0(p);
  grid.sync();
  extern __shared__ __attribute__((aligned(16))) unsigned char lds_dyn[];
  volatile LAS unsigned* bst = (volatile LAS unsigned*)(lds_dyn + 131072 + 64);
  if (threadIdx.x < 8) bst[threadIdx.x] = 0u;
  __syncthreads();
  const XcdBarrier xbar = xcd_barrier_post((unsigned*)(p.ws + OFF_BAR), bst);
  xcd_barrier(xbar);
  if (threadIdx.x == 0) {
    unsigned gi = 0u, nx = 0u, nloc = 1u;
    for (unsigned j = 0; j < 16; ++j) { const unsigned c = xb_ld((unsigned*)(p.ws + OFF_BAR) + XB_XCNT(j)); if (c) { ++nx; if (j < xbar.x) ++gi; } if (j == xbar.x) nloc = c ? c : 1u; }
    bst[4] = gi; bst[5] = nx ? nx : 1u; bst[6] = nloc;
  }
  __syncthreads();
  Grp gr;
  gr.gi = __builtin_amdgcn_readfirstlane((int)bst[4]); gr.nx = __builtin_amdgcn_readfirstlane((int)bst[5]);
  gr.rank = __builtin_amdgcn_readfirstlane((int)bst[3]); gr.nloc = __builtin_amdgcn_readfirstlane((int)bst[6]);
  for (int l = 0; l < 4; ++l) {
    const int nMpost = (l < 3) ? 72 : 64;
    for (int s = 0; s < 13; ++s) {
      const int nM = (s < 8) ? 72 : nMpost;
      if (s == 0 || s == 3 || s == 10) {
        const float* MODc = (const float*)(p.ws + OFF_MOD) + 8 * 9216 + 2048;
        const float* pend = nullptr; float pc = 0.5f;
        if (s == 0) { if (l > 0) pend = MODc + (size_t)(l - 1) * 9 * 9216 + 2 * 3072; }
        else if (s == 3) pend = MODc + (size_t)l * 9 * 9216;
        else { if (l < 3) { pend = MODc + (size_t)l * 9 * 9216 + 3072; pc = 1.f; } }
        phase_adaln(p, gr, l, s == 10 ? 2 : s / 3, nM * 256, pend, pc, (l == 0 && s == 0) ? p.x : nullptr, (l == 0 && s <= 3) ? p.ctx : nullptr);
      }
      else if (s == 5) phase_MA(p, gr, l);
      else if (s == 6) phase_MB(p, gr, l);
      else if (s == 7) phase_MC(p, gr, l);
      else {
        bf16_t* H = (bf16_t*)(p.ws + OFF_H); bf16_t* ACT = (bf16_t*)(p.ws + OFF_ACT); float* X = (float*)(p.ws + OFF_X);
        bf16_t* MIX = (bf16_t*)(p.ws + OFF_MIX); bf16_t* GA = (bf16_t*)(p.ws + OFF_GA);
        const float* MOD = (const float*)(p.ws + OFF_MOD) + (size_t)l * 9 * 9216;
        int epi, nN, K; const bf16_t* A; const bf16_t* Bt; EpiArgs ea{nullptr, nullptr, nullptr, 0.f, 0, 0, (float*)(p.ws + OFF_PART), (const float*)(p.ws + OFF_X)};
        if (s == 1 || s == 11) { const int f = (s == 11); epi = 1; A = H; Bt = (const bf16_t*)(p.ws + OFF_W1T) + (size_t)(l * 2 + f) * 5632 * 1024; nN = 22; K = 1024; ea.outb = ACT; ea.ldo = DFF; }
        else if (s == 2 || s == 12) { const int f = (s == 12); epi = 2; A = ACT; Bt = (const bf16_t*)(p.ws + OFF_W2T) + (size_t)(l * 2 + f) * 1024 * 2816; nN = 4; K = 2816; ea.outf = X; ea.aux = MOD + (f ? 2 : 0) * 3072 + 2048; ea.coef = 0.5f; ea.ldo = 1024; if (l == 0 && f == 0) ea.xin = p.x; }
        else if (s == 4) { epi = 0; A = H; Bt = (const bf16_t*)(p.ws + OFF_WINT) + (size_t)l * 2304 * 1024; nN = 9; K = 1024; ea.outf = (float*)(p.ws + OFF_P); ea.ldo = DIN; }
        else if (s == 8) { epi = 3; A = GA; Bt = (const bf16_t*)(p.ws + OFF_GLUT) + (size_t)l * 512 * 256; nN = 2; K = 256; ea.outb = MIX; ea.aux = p.glu_b + l * 512; ea.ldo = 1024; ea.coloff = 768; }
        else { epi = 2; A = MIX; Bt = (const bf16_t*)(p.ws + OFF_WOT) + (size_t)l * 1024 * 1024; nN = 4; K = 1024; ea.outf = X; ea.aux = MOD + 1 * 3072 + 2048; ea.coef = 1.f; ea.ldo = 1024; }
        gemm_phase(gr, epi, A, Bt, nM, nN, K, ea);
      }
      grp_barrier(xbar);
    }
  }
  phase_final(p, gr);
}

extern "C" void kernel_launch(void* const* d_in, const int* in_sizes, int n_in, void* d_out, int out_size, void* d_ws, size_t ws_size, hipStream_t stream) {
  static int grid = 0;
  if (grid == 0) {
    int dev = 0, cus = 0, per_cu = 0;
    hipGetDevice(&dev);
    hipDeviceGetAttribute(&cus, hipDeviceAttributeMultiprocessorCount, dev);
    if (hipFuncSetAttribute((const void*)mega, hipFuncAttributeMaxDynamicSharedMemorySize, LDS_BYTES) != hipSuccess) fprintf(stderr, "hipFuncSetAttribute failed\n");
    if (hipOccupancyMaxActiveBlocksPerMultiprocessor(&per_cu, (const void*)mega, NTHR, LDS_BYTES) != hipSuccess || per_cu < 1) { fprintf(stderr, "occupancy query says %d\n", per_cu); per_cu = 1; }
    (void)hipGetLastError();
    if (cus <= 0) cus = 256;
    grid = cus;
    if (ws_size < WS_END) fprintf(stderr, "workspace too small: %zu < %zu\n", ws_size, (size_t)WS_END);
  }
  Params p{};
  const float** pf = (const float**)&p;
  for (int i = 0; i < 25; ++i) pf[i] = (const float*)d_in[i];
  p.out = (float*)d_out; p.ws = (unsigned char*)d_ws;
  void* args[] = {&p};
  hipError_t e = hipLaunchCooperativeKernel((const void*)mega, dim3(grid), dim3(NTHR), args, LDS_BYTES, stream);
  if (e != hipSuccess) fprintf(stderr, "cooperative launch failed: %s (grid %d)\n", hipGetErrorString(e), grid);
}
```

```cpp
#include <hip/hip_runtime.h>
#include <hip/hip_cooperative_groups.h>
#include <cstdio>
namespace cg = cooperative_groups;

typedef unsigned short bf16_t;
typedef short bf16x8 __attribute__((ext_vector_type(8)));
typedef short s16x4 __attribute__((ext_vector_type(4)));
typedef float f32x4 __attribute__((ext_vector_type(4)));
typedef float f32x16 __attribute__((ext_vector_type(16)));
#define DEVI __device__ __forceinline__

constexpr int NLAT = 16384, NCTX = 2048, NROW = 18432, DM = 1024, DFF = 2816, DIN = 2304;
constexpr int NTHR = 512;
constexpr int LDS_BYTES = 131072 + 256;

constexpr size_t OFF_X    = 0;
constexpr size_t OFF_H    = OFF_X    + (size_t)NROW * DM * 4;
constexpr size_t OFF_P    = OFF_H    + (size_t)NROW * DM * 2;
constexpr size_t OFF_MIX  = OFF_P    + (size_t)NROW * DIN * 4;
constexpr size_t OFF_OA   = OFF_MIX  + (size_t)NROW * DM * 2;
constexpr size_t OFF_YS   = OFF_OA   + (size_t)2 * NROW * 256 * 4;
constexpr size_t OFF_GA   = OFF_YS   + (size_t)2 * NROW * 256 * 4;
constexpr size_t OFF_W1T  = OFF_GA   + (size_t)NROW * 256 * 2;
constexpr size_t OFF_W2T  = OFF_W1T  + (size_t)8 * 5632 * 1024 * 2;
constexpr size_t OFF_WINT = OFF_W2T  + (size_t)8 * 1024 * 2816 * 2;
constexpr size_t OFF_WOT  = OFF_WINT + (size_t)4 * 2304 * 1024 * 2;
constexpr size_t OFF_GLUT = OFF_WOT  + (size_t)4 * 1024 * 1024 * 2;
constexpr size_t OFF_MOD  = OFF_GLUT + (size_t)4 * 512 * 256 * 2;
constexpr size_t OFF_ABAR = OFF_MOD  + (size_t)4 * 9 * 9216 * 4;
constexpr size_t OFF_BBAR = OFF_ABAR + (size_t)8192 * 2 * 4;
constexpr size_t OFF_LB   = OFF_BBAR + (size_t)8192 * 32 * 4;
constexpr size_t OFF_ROPE = OFF_LB   + (size_t)4 * 512 * 4;
constexpr size_t OFF_CNT  = OFF_ROPE + (size_t)2048 * 4;
constexpr size_t OFF_BAR  = OFF_CNT  + 256;
constexpr size_t OFF_PART = (OFF_BAR + 5504 * 4 + 255) / 256 * 256;
constexpr size_t OFF_ACT  = OFF_PART + (size_t)4 * NCTX * DM * 4;
constexpr size_t WS_END   = OFF_ACT  + (size_t)NROW * DFF * 2;

struct Grp { int gi, nx, rank, nloc; };
struct Params {
  const float *x, *c, *ctx, *c_ctx, *ada_w, *ada_b, *norm_g, *ffn_w1, *ffn_w2, *w_in, *w_out, *lbnd, *hnorm_g, *sink;
  const float *a_re, *a_im, *log_dt, *b_re, *b_im, *c_re, *c_im, *s5_d, *glu_w, *glu_b, *final_g;
  float* out;
  unsigned char* ws;
};

DEVI unsigned short f2bf(float x) { const __bf16 b = (__bf16)x; return __builtin_bit_cast(unsigned short, b); }
DEVI float silu_f(float x) { return x * __builtin_amdgcn_rcpf(1.f + __expf(-x)); }
DEVI float shx(float v, int k, int lane) { return __int_as_float(__builtin_amdgcn_ds_bpermute((lane ^ k) << 2, __float_as_int(v))); }
DEVI float wave_sum(float v, int lane) { for (int o = 32; o > 0; o >>= 1) v += shx(v, o, lane); return v; }

DEVI void transpose_tile(const float* __restrict__ src, bf16_t* __restrict__ dst, int K, int N, int k0, int n0, int drow0, float* T) {
  const int tid = threadIdx.x;
  { const int r = tid >> 4, c4 = tid & 15;
    for (int rr = r; rr < 64; rr += 32) {
      const float4 v = *(const float4*)(src + (size_t)(k0 + rr) * N + n0 + c4 * 4);
      T[rr * 65 + c4 * 4 + 0] = v.x; T[rr * 65 + c4 * 4 + 1] = v.y; T[rr * 65 + c4 * 4 + 2] = v.z; T[rr * 65 + c4 * 4 + 3] = v.w;
    } }
  __syncthreads();
  { const int n = tid >> 3, k8 = tid & 7;
    bf16x8 o;
#pragma unroll
    for (int i = 0; i < 8; ++i) o[i] = (short)f2bf(T[(k8 * 8 + i) * 65 + n]);
    *(bf16x8*)(dst + (size_t)(drow0 + n) * K + k0 + k8 * 8) = o; }
  __syncthreads();
}
DEVI int perm_row(int n0, int half) { const int hi = n0 >= half; const int j0 = n0 - hi * half; return (j0 >> 7) * 256 + hi * 128 + (j0 & 127); }

__device__ void phase0(const Params& p) {
  extern __shared__ __attribute__((aligned(16))) unsigned char lds_raw[];
  float* L = (float*)lds_raw;
  const int tid = threadIdx.x, nb = gridDim.x, bid = blockIdx.x;
  if (bid == 0) { if (tid < 64) ((int*)(p.ws + OFF_CNT))[tid] = 0; for (int i = tid; i < 5504; i += NTHR) ((unsigned*)(p.ws + OFF_BAR))[i] = 0u; }
  { const int gi = bid * NTHR + tid, gs = nb * NTHR;
    float* rc = (float*)(p.ws + OFF_ROPE); float* rs = rc + 1024;
    for (int e = gi; e < 1024; e += gs) { const int pos = e >> 4, i = e & 15; const float inv = powf(10000.f, -(float)i / 16.f); const float a = (float)pos * inv; rc[e] = cosf(a); rs[e] = sinf(a); }
    float* lb = (float*)(p.ws + OFF_LB);
    for (int e = gi; e < 512; e += gs) {
      const float v0 = p.lbnd[e], v1 = p.lbnd[512 + e], v2 = p.lbnd[1024 + e], v3 = p.lbnd[1536 + e];
      const float mx = fmaxf(fmaxf(v0, v1), fmaxf(v2, v3));
      const float e0 = expf(v0 - mx), e1 = expf(v1 - mx), e2 = expf(v2 - mx), e3 = expf(v3 - mx);
      const float inv = 1.f / (e0 + e1 + e2 + e3);
      lb[e] = 0.f; lb[512 + e] = e1 * inv; lb[1024 + e] = (e1 + e2) * inv; lb[1536 + e] = (e1 + e2 + e3) * inv;
    }
    float* ab = (float*)(p.ws + OFF_ABAR); float* bb = (float*)(p.ws + OFF_BBAR);
    for (int e = gi; e < 8192; e += gs) {
      const int pp = e & 63, g = (e >> 6) & 15, l = e >> 11;
      const float are = p.a_re[e], aim = p.a_im[e];
      const float dt = expf(p.log_dt[e >> 6]);
      const float mag = expf(are * dt), ang = aim * dt;
      const float abr = mag * cosf(ang), abi = mag * sinf(ang);
      const float den = are * are + aim * aim;
      const float cr = ((abr - 1.f) * are + abi * aim) / den;
      const float ci = (abi * are - (abr - 1.f) * aim) / den;
      ab[e * 2] = abr; ab[e * 2 + 1] = abi;
      const float* br = p.b_re + ((size_t)(l * 16 + g) * 64 + pp) * 16; const float* bi = p.b_im + ((size_t)(l * 16 + g) * 64 + pp) * 16;
      for (int c = 0; c < 16; ++c) { const float r = br[c], i2 = bi[c]; bb[((size_t)((e >> 6) * 2 + 0) * 64 + pp) * 16 + c] = cr * r - ci * i2; bb[((size_t)((e >> 6) * 2 + 1) * 64 + pp) * 16 + c] = cr * i2 + ci * r; }
    }
  }
  constexpr int N_MOD = 144;
  if (bid < N_MOD) {
    const int it = bid;
    float* SC = L; float* RED = L + 9216;
    for (int e = tid; e < 9216; e += NTHR) { const int r = e >> 10, k = e & 1023; const float v = (r < 8) ? p.c[r * 1024 + k] : p.c_ctx[k]; SC[e] = silu_f(v); }
    __syncthreads();
    const int cb = it * 256, l = cb / 9216, n0 = cb % 9216;
    const int cq = tid & 63, kg = tid >> 6;
    float acc[9][4];
#pragma unroll
    for (int r = 0; r < 9; ++r) { acc[r][0] = 0.f; acc[r][1] = 0.f; acc[r][2] = 0.f; acc[r][3] = 0.f; }
    const float* wp = p.ada_w + ((size_t)l * 1024 + kg * 128) * 9216 + n0 + cq * 4;
#pragma unroll 8
    for (int kk = 0; kk < 128; ++kk) {
      const float4 w = *(const float4*)(wp + (size_t)kk * 9216);
#pragma unroll
      for (int r = 0; r < 9; ++r) { const float s = SC[r * 1024 + kg * 128 + kk]; acc[r][0] += s * w.x; acc[r][1] += s * w.y; acc[r][2] += s * w.z; acc[r][3] += s * w.w; }
    }
#pragma unroll
    for (int r = 0; r < 9; ++r) *(float4*)(RED + (kg * 9 + r) * 256 + cq * 4) = make_float4(acc[r][0], acc[r][1], acc[r][2], acc[r][3]);
    __syncthreads();
    float* mod = (float*)(p.ws + OFF_MOD);
    for (int e = tid; e < 2304; e += NTHR) {
      const int r = e >> 8, cc = e & 255; float s = p.ada_b[l * 9216 + n0 + cc];
      for (int k2 = 0; k2 < 8; ++k2) s += RED[(k2 * 9 + r) * 256 + cc];
      mod[(size_t)(l * 9 + r) * 9216 + n0 + cc] = s;
    }
    __syncthreads();
  }
  {
    constexpr int T_W1 = 8 * 16 * 22, T_W2 = 8 * 44 * 4, T_WIN = 4 * 16 * 9, T_WO = 4 * 16 * 4, T_GLU = 4 * 4 * 2;
    constexpr int N_TR = T_W1 + T_W2 + T_WIN + T_WO + T_GLU;
    float* T = L;
    for (int t0 = bid; t0 < N_TR; t0 += nb) {
      int t = t0; const float* srcp; bf16_t* dstp; int K, N, k0, n0, half;
      if (t < T_W1) { const int mat = t / 352, tl = t % 352; k0 = (tl / 22) * 64; n0 = (tl % 22) * 256; K = 1024; N = 5632; half = 2816;
        srcp = p.ffn_w1 + (size_t)mat * 1024 * 5632; dstp = (bf16_t*)(p.ws + OFF_W1T) + (size_t)mat * 5632 * 1024;
      } else if ((t -= T_W1) < T_W2) { const int mat = t / 176, tl = t % 176; k0 = (tl / 4) * 64; n0 = (tl % 4) * 256; K = 2816; N = 1024; half = 0;
        srcp = p.ffn_w2 + (size_t)mat * 2816 * 1024; dstp = (bf16_t*)(p.ws + OFF_W2T) + (size_t)mat * 1024 * 2816;
      } else if ((t -= T_W2) < T_WIN) { const int mat = t / 144, tl = t % 144; k0 = (tl / 9) * 64; n0 = (tl % 9) * 256; K = 1024; N = 2304; half = 0;
        srcp = p.w_in + (size_t)mat * 1024 * 2304; dstp = (bf16_t*)(p.ws + OFF_WINT) + (size_t)mat * 2304 * 1024;
      } else if ((t -= T_WIN) < T_WO) { const int mat = t / 64, tl = t % 64; k0 = (tl / 4) * 64; n0 = (tl % 4) * 256; K = 1024; N = 1024; half = 0;
        srcp = p.w_out + (size_t)mat * 1024 * 1024; dstp = (bf16_t*)(p.ws + OFF_WOT) + (size_t)mat * 1024 * 1024;
      } else { t -= T_WO; const int mat = t / 8, tl = t % 8; k0 = (tl / 2) * 64; n0 = (tl % 2) * 256; K = 256; N = 512; half = 256;
        srcp = p.glu_w + (size_t)mat * 256 * 512; dstp = (bf16_t*)(p.ws + OFF_GLUT) + (size_t)mat * 512 * 256;
      }
      { const int r = tid >> 6, c4 = tid & 63;
        float4 v[8];
#pragma unroll
        for (int i = 0; i < 8; ++i) v[i] = *(const float4*)(srcp + (size_t)(k0 + r + 8 * i) * N + n0 + c4 * 4);
#pragma unroll
        for (int i = 0; i < 8; ++i) { float* tp = T + (r + 8 * i) * 257 + c4 * 4; tp[0] = v[i].x; tp[1] = v[i].y; tp[2] = v[i].z; tp[3] = v[i].w; } }
      __syncthreads();
      { const int nn = tid >> 1, kh = tid & 1;
        const int ng = n0 + (nn & 128);
        const int drow = (half ? perm_row(ng, half) : ng) + (nn & 127);
#pragma unroll
        for (int q = 0; q < 4; ++q) {
          const int k8 = kh * 4 + q; bf16x8 o;
#pragma unroll
          for (int i = 0; i < 8; ++i) o[i] = (short)f2bf(T[(k8 * 8 + i) * 257 + nn]);
          *(bf16x8*)(dstp + (size_t)drow * K + k0 + k8 * 8) = o;
        } }
      __syncthreads();
    }
  }
}

__device__ void phase_adaln(const Params& p, const Grp gr, int l, int i, int nrows, const float* pend_gate, const float pend_coef, const float* xlat, const float* xctx) {
  int tid0 = threadIdx.x; asm volatile("" : "+v"(tid0));
  const int lane = tid0 & 63, gw = blockIdx.x * 8 + (tid0 >> 6), nw = gridDim.x * 8;
  float* X = (float*)(p.ws + OFF_X); bf16_t* H = (bf16_t*)(p.ws + OFF_H);
  const float* PART = (const float*)(p.ws + OFF_PART);
  const float* g = p.norm_g + (size_t)(l * 3 + i) * 1024;
  const int lw = gr.rank * 8 + (tid0 >> 6), nlw = gr.nloc * 8;
  const int per_b = (nrows > NLAT) ? 2304 : 2048;
  for (int xb = gr.gi; xb < 8; xb += gr.nx)
  for (int it = lw; it < per_b; it += nlw) {
    const int row = (it < 2048) ? xb * 2048 + it : NLAT + xb * 256 + (it - 2048);
    const int mr = (row < NLAT) ? (row >> 11) : 8;
    const float* mod = (const float*)(p.ws + OFF_MOD) + (size_t)(l * 9 + mr) * 9216 + i * 3072;
    float4 v[4]; float ss = 0.f;
    const float* xr = (row < NLAT) ? (xlat ? xlat + (size_t)row * 1024 : X + (size_t)row * 1024) : (xctx ? xctx + (size_t)(row - NLAT) * 1024 : X + (size_t)row * 1024);
#pragma unroll
    for (int q = 0; q < 4; ++q) v[q] = *(const float4*)(xr + q * 256 + lane * 4);
    if (pend_gate != nullptr && row >= NLAT) {
#pragma unroll
      for (int q = 0; q < 4; ++q) {
        const int col = q * 256 + lane * 4; const size_t o = (size_t)(row - NLAT) * 1024 + col;
        const float4 a = *(const float4*)(PART + o), b = *(const float4*)(PART + (size_t)NCTX * 1024 + o), c = *(const float4*)(PART + (size_t)2 * NCTX * 1024 + o), d = *(const float4*)(PART + (size_t)3 * NCTX * 1024 + o);
        const float4 gt = *(const float4*)(pend_gate + col);
        v[q].x += pend_coef * gt.x * ((a.x + b.x) + (c.x + d.x)); v[q].y += pend_coef * gt.y * ((a.y + b.y) + (c.y + d.y));
        v[q].z += pend_coef * gt.z * ((a.z + b.z) + (c.z + d.z)); v[q].w += pend_coef * gt.w * ((a.w + b.w) + (c.w + d.w));
        *(float4*)(X + (size_t)row * 1024 + col) = v[q];
      }
    }
#pragma unroll
    for (int q = 0; q < 4; ++q) ss += v[q].x * v[q].x + v[q].y * v[q].y + v[q].z * v[q].z + v[q].w * v[q].w;
    ss = wave_sum(ss, lane);
    const float rstd = rsqrtf(ss * (1.f / 1024.f) + 1e-6f);
#pragma unroll
    for (int q = 0; q < 4; ++q) {
      const int col = q * 256 + lane * 4;
      const float4 gg = *(const float4*)(g + col), sh = *(const float4*)(mod + col), sc = *(const float4*)(mod + 1024 + col);
      s16x4 o;
      o[0] = (short)f2bf(v[q].x * rstd * gg.x * (1.f + sc.x) + sh.x); o[1] = (short)f2bf(v[q].y * rstd * gg.y * (1.f + sc.y) + sh.y);
      o[2] = (short)f2bf(v[q].z * rstd * gg.z * (1.f + sc.z) + sh.z); o[3] = (short)f2bf(v[q].w * rstd * gg.w * (1.f + sc.w) + sh.w);
      *(s16x4*)(H + (size_t)row * 1024 + col) = o;
    }
  }
}
__device__ void phase_final(const Params& p, const Grp gr) {
  int tid0 = threadIdx.x; asm volatile("" : "+v"(tid0));
  const int lane = tid0 & 63, gw = blockIdx.x * 8 + (tid0 >> 6), nw = gridDim.x * 8;
  const float* X = (const float*)(p.ws + OFF_X);
  const int lw = gr.rank * 8 + (tid0 >> 6), nlw = gr.nloc * 8;
  for (int xb = gr.gi; xb < 8; xb += gr.nx)
  for (int it = lw; it < 2048; it += nlw) {
    const int row = xb * 2048 + it;
    float4 v[4]; float ss = 0.f;
#pragma unroll
    for (int q = 0; q < 4; ++q) { v[q] = *(const float4*)(X + (size_t)row * 1024 + q * 256 + lane * 4); ss += v[q].x * v[q].x + v[q].y * v[q].y + v[q].z * v[q].z + v[q].w * v[q].w; }
    ss = wave_sum(ss, lane);
    const float rstd = rsqrtf(ss * (1.f / 1024.f) + 1e-6f);
#pragma unroll
    for (int q = 0; q < 4; ++q) {
      const int col = q * 256 + lane * 4; const float4 gg = *(const float4*)(p.final_g + col);
      *(float4*)(p.out + (size_t)row * 1024 + col) = make_float4(v[q].x * rstd * gg.x, v[q].y * rstd * gg.y, v[q].z * rstd * gg.z, v[q].w * rstd * gg.w);
    }
  }
}

constexpr int BM = 256, BK = 64, HALF = 128, HT = HALF * BK;
DEVI int lds_byte(int r, int c) { const int st = (r >> 4) * 2 + (c >> 5), rr = r & 15, cc = c & 31, ob = rr * 64 + cc * 2; return st * 1024 + (ob ^ (((ob >> 9) & 1) << 5)); }
DEVI void stage_rc(int b, int& R, int& C) { const int st = b / 1024, sb = b % 1024, swz = sb ^ (((sb >> 9) & 1) << 5); R = (st >> 1) * 16 + swz / 64; C = (st & 1) * 32 + (swz % 64) / 2; }

struct EpiArgs { float* outf; bf16_t* outb; const float* aux; float coef; int ldo; int coloff; float* part; const float* xin; };

__device__ __forceinline__ void gemm_phase(const Grp gr, const int EPI, const bf16_t* __restrict__ A, const bf16_t* __restrict__ Bt, int nM, int nN, int K, const EpiArgs ea) {
  extern __shared__ __attribute__((aligned(16))) unsigned char lds_raw[];
  bf16_t* shm = (bf16_t*)lds_raw;
#define SA(b, h) (shm + ((b) * 2 + (h)) * HT)
#define SB(b, h) (shm + (4 + (b) * 2 + (h)) * HT)
#define STAGE(P_, BASE, br, kt) do { const char* _sb = (const char*)(BASE) + ((long)(br) * K + (long)kofs + (long)(kt) * BK) * 2; \
    unsigned _v0 = voff0, _v1 = voff1; asm volatile("" : "+v"(_v0), "+v"(_v1)); \
    __builtin_amdgcn_global_load_lds((const unsigned*)(_sb + (size_t)_v0), (unsigned*)((char*)(P_) + lb0), 16, 0, 0); \
    __builtin_amdgcn_global_load_lds((const unsigned*)(_sb + (size_t)_v1), (unsigned*)((char*)(P_) + lb0 + 8192), 16, 0, 0); } while (0)
#define LDA(dst, b, h) for (int m = 0; m < 4; ++m) for (int k = 0; k < 2; ++k) \
    dst[m][k] = *reinterpret_cast<const bf16x8*>((char*)SA(b, h) + aoff + m * 2048 + k * 1024)
#define LDB(dst, b, h) for (int n = 0; n < 2; ++n) for (int k = 0; k < 2; ++k) \
    dst[n][k] = *reinterpret_cast<const bf16x8*>((char*)SB(b, h) + boff + n * 2048 + k * 1024)
#define MMA(ai, bj, At_, Bt_) do { __builtin_amdgcn_s_setprio(1); \
    for (int m = 0; m < 4; ++m) for (int n = 0; n < 2; ++n) for (int k = 0; k < 2; ++k) \
      acc[ai][bj][m][n] = __builtin_amdgcn_mfma_f32_16x16x32_bf16(Bt_[n][k], At_[m][k], acc[ai][bj][m][n], 0, 0, 0); \
    __builtin_amdgcn_s_setprio(0); } while (0)
#define WAIT_V(n) asm volatile("s_waitcnt vmcnt(" #n ")" ::: "memory")
#define WAIT_L(n) asm volatile("s_waitcnt lgkmcnt(" #n ")" ::: "memory")
#define BAR __builtin_amdgcn_s_barrier()
#define SCHED __builtin_amdgcn_sched_barrier(0)
  const int G = gridDim.x;
  int tidx = threadIdx.x; asm volatile("" : "+v"(tidx));
  const int wid = __builtin_amdgcn_readfirstlane(tidx >> 6), lane = tidx & 63, wr = wid >> 2, wc = wid & 3, fr = lane & 15, fq = lane >> 4;
  const int nt = K / BK;
  const int lb0 = tidx * 16;
  unsigned voff0, voff1;
  { int r0, c0; stage_rc(lb0, r0, c0); voff0 = (unsigned)(r0 * K + c0) * 2u; stage_rc(lb0 + 8192, r0, c0); voff1 = (unsigned)(r0 * K + c0) * 2u; }
  const int swz_l = lds_byte(fr, fq * 8);
  const int aoff = wr * 8192 + swz_l, boff = wc * 4096 + swz_l;
  const int pR = (nM > 64) ? 9 : 8;
  const bool tailk = (EPI == 2) && (pR == 9);
  const int nfullb = (tailk ? 8 : pR) * nN, Ub = nfullb + (tailk ? 4 * nN : 0);
  const int nbg = (8 - gr.gi + gr.nx - 1) / gr.nx;
  for (int unit = gr.rank; unit < nbg * Ub; unit += gr.nloc) {
    const int bsel = gr.gi + (unit / Ub) * gr.nx, u = unit % Ub;
    int pm, pn, kofs = 0, ntu = nt, split = -1;
    if (u < nfullb) {
      const int rdiv = tailk ? 8 : pR; const int rt = u % rdiv; pn = u / rdiv; pm = (rt < 8) ? 8 * bsel + rt : 64 + bsel;
    } else {
      const int q = u - nfullb; split = q & 3; pn = q >> 2; pm = 64 + bsel;
      int kt0;
      if (nt == 44) { kt0 = (split == 0) ? 0 : (split == 1) ? 12 : (split == 2) ? 24 : 34; ntu = (split < 2) ? 12 : 10; }
      else { ntu = nt >> 2; kt0 = split * ntu; }
      kofs = kt0 * BK;
    }
    const int brow = pm * BM, bcol = pn * BM;
    f32x4 acc[2][2][4][2];
#pragma unroll
    for (int a = 0; a < 2; ++a)
#pragma unroll
      for (int b = 0; b < 2; ++b)
#pragma unroll
        for (int m = 0; m < 4; ++m)
#pragma unroll
          for (int n = 0; n < 2; ++n) acc[a][b][m][n] = f32x4{0.f, 0.f, 0.f, 0.f};
    bf16x8 At[4][2], B0[2][2], B1[2][2];
    STAGE(SB(0, 0), Bt, bcol, 0); STAGE(SA(0, 0), A, brow, 0);
    STAGE(SB(0, 1), Bt, bcol + HALF, 0); STAGE(SA(0, 1), A, brow + HALF, 0);
    if (wr == 1) BAR;
    WAIT_V(4); BAR;
    STAGE(SB(1, 0), Bt, bcol, 1); STAGE(SA(1, 0), A, brow, 1); STAGE(SB(1, 1), Bt, bcol + HALF, 1);
    WAIT_V(6); BAR;
    for (int t = 0; t < ntu - 2; t += 2) {
      LDB(B0, 0, 0); SCHED; LDA(At, 0, 0); STAGE(SA(1, 1), A, brow + HALF, t + 1);
      WAIT_L(8); BAR; WAIT_L(0); MMA(0, 0, At, B0); BAR; SCHED;
      LDB(B1, 0, 1); STAGE(SB(0, 0), Bt, bcol, t + 2);
      BAR; WAIT_L(0); MMA(0, 1, At, B1); BAR;
      LDA(At, 0, 1); STAGE(SA(0, 0), A, brow, t + 2);
      BAR; WAIT_L(0); MMA(1, 0, At, B0); BAR; SCHED;
      STAGE(SB(0, 1), Bt, bcol + HALF, t + 2);
      WAIT_V(6); BAR; MMA(1, 1, At, B1); BAR;
      LDB(B0, 1, 0); SCHED; LDA(At, 1, 0); STAGE(SA(0, 1), A, brow + HALF, t + 2);
      WAIT_L(8); BAR; WAIT_L(0); MMA(0, 0, At, B0); BAR; SCHED;
      LDB(B1, 1, 1); STAGE(SB(1, 0), Bt, bcol, t + 3);
      BAR; WAIT_L(0); MMA(0, 1, At, B1); BAR;
      LDA(At, 1, 1); STAGE(SA(1, 0), A, brow, t + 3);
      BAR; WAIT_L(0); MMA(1, 0, At, B0); BAR; SCHED;
      STAGE(SB(1, 1), Bt, bcol + HALF, t + 3);
      WAIT_V(6); BAR; MMA(1, 1, At, B1); BAR;
    }
    { LDB(B0, 0, 0); LDA(At, 0, 0); STAGE(SA(1, 1), A, brow + HALF, ntu - 1);
      BAR; WAIT_L(0); MMA(0, 0, At, B0); BAR;
      LDB(B1, 0, 1); BAR; WAIT_L(0); MMA(0, 1, At, B1); BAR;
      LDA(At, 0, 1); WAIT_V(4); BAR; WAIT_L(0); MMA(1, 0, At, B0); MMA(1, 1, At, B1); BAR; }
    { LDB(B0, 1, 0); LDA(At, 1, 0); WAIT_V(2); BAR; WAIT_L(0); MMA(0, 0, At, B0); BAR;
      LDB(B1, 1, 1); WAIT_V(0); BAR; WAIT_L(0); MMA(0, 1, At, B1); BAR;
      LDA(At, 1, 1); BAR; WAIT_L(0); MMA(1, 0, At, B0); MMA(1, 1, At, B1); BAR; }
    if (wr == 0) BAR;
    const int mr = (brow < NLAT) ? (brow >> 11) : 8;
    int t2 = threadIdx.x; asm volatile("" : "+v"(t2));
    const int fr_e = t2 & 15, fq_e = (t2 >> 4) & 3;
#define EPI_LOOP(BODY) _Pragma("unroll") for (int ai = 0; ai < 2; ++ai) _Pragma("unroll") for (int m = 0; m < 4; ++m) { \
      const size_t row = (size_t)(brow + ai * HALF + wr * 64 + m * 16 + fr_e); BODY }
    if (EPI == 0) {
      EPI_LOOP(
        _Pragma("unroll") for (int bj = 0; bj < 2; ++bj) _Pragma("unroll") for (int n = 0; n < 2; ++n) { const f32x4 v = acc[ai][bj][m][n];
          *(float4*)(ea.outf + row * ea.ldo + bcol + bj * HALF + wc * 32 + n * 16 + fq_e * 4) = make_float4(v[0], v[1], v[2], v[3]); } )
    } else if (EPI == 1) {
      EPI_LOOP(
        _Pragma("unroll") for (int n = 0; n < 2; ++n) { const f32x4 gt = acc[ai][0][m][n]; const f32x4 up = acc[ai][1][m][n]; s16x4 o;
          _Pragma("unroll") for (int j = 0; j < 4; ++j) o[j] = (short)f2bf(gt[j] * __builtin_amdgcn_rcpf(1.f + __expf(-gt[j])) * up[j]);
          *(s16x4*)(ea.outb + row * ea.ldo + pn * HALF + wc * 32 + n * 16 + fq_e * 4) = o; } )
    } else if (EPI == 2 && split >= 0) {
      EPI_LOOP(
        _Pragma("unroll") for (int bj = 0; bj < 2; ++bj) _Pragma("unroll") for (int n = 0; n < 2; ++n) { const f32x4 v = acc[ai][bj][m][n];
          *(float4*)(ea.part + ((size_t)split * NCTX + (row - NLAT)) * 1024 + bcol + bj * HALF + wc * 32 + n * 16 + fq_e * 4) = make_float4(v[0], v[1], v[2], v[3]); } )
    } else if (EPI == 2) {
      EPI_LOOP(
        _Pragma("unroll") for (int bj = 0; bj < 2; ++bj) _Pragma("unroll") for (int n = 0; n < 2; ++n) { const int col = bcol + bj * HALF + wc * 32 + n * 16 + fq_e * 4;
          const f32x4 v = acc[ai][bj][m][n]; const float4 g = *(const float4*)(ea.aux + mr * 9216 + col);
          float4* xp = (float4*)(ea.outf + row * 1024 + col); float4 x = *(const float4*)(ea.xin + row * 1024 + col);
          x.x += ea.coef * g.x * v[0]; x.y += ea.coef * g.y * v[1]; x.z += ea.coef * g.z * v[2]; x.w += ea.coef * g.w * v[3]; *xp = x; } )
    } else {
      EPI_LOOP(
        _Pragma("unroll") for (int n = 0; n < 2; ++n) { const int cl = pn * HALF + wc * 32 + n * 16 + fq_e * 4;
          const f32x4 av = acc[ai][0][m][n]; const f32x4 bv = acc[ai][1][m][n];
          const float4 ba = *(const float4*)(ea.aux + cl); const float4 bb = *(const float4*)(ea.aux + 256 + cl); s16x4 o;
          o[0] = (short)f2bf((av[0] + ba.x) * __builtin_amdgcn_rcpf(1.f + __expf(-(bv[0] + bb.x)))); o[1] = (short)f2bf((av[1] + ba.y) * __builtin_amdgcn_rcpf(1.f + __expf(-(bv[1] + bb.y))));
          o[2] = (short)f2bf((av[2] + ba.z) * __builtin_amdgcn_rcpf(1.f + __expf(-(bv[2] + bb.z)))); o[3] = (short)f2bf((av[3] + ba.w) * __builtin_amdgcn_rcpf(1.f + __expf(-(bv[3] + bb.w))));
          *(s16x4*)(ea.outb + row * ea.ldo + ea.coloff + cl) = o; } )
    }
#undef EPI_LOOP
    __syncthreads();
  }
#undef SA
#undef SB
}

DEVI int seq_row(int b, int dir, int i) {
  if (i < 256) { const int s = dir ? 255 - i : i; return NLAT + b * 256 + s; }
  const int j = i - 256; const int t = dir ? 2047 - j : j; return b * 2048 + t;
}

DEVI int mirror_blk(int nf) { return nf < 4 ? 3 - nf : 39 - nf; }

DEVI bf16x8 pk8(float a0, float a1, float a2, float a3, float b0, float b1, float b2, float b3) {
  bf16x8 r; r[0] = (short)f2bf(a0); r[1] = (short)f2bf(a1); r[2] = (short)f2bf(a2); r[3] = (short)f2bf(a3);
  r[4] = (short)f2bf(b0); r[5] = (short)f2bf(b1); r[6] = (short)f2bf(b2); r[7] = (short)f2bf(b3); return r;
}
template <int C> DEVI float dppz(float v) { return __int_as_float(__builtin_amdgcn_update_dpp(0, __float_as_int(v), C, 0xf, 0xf, true)); }
DEVI float bperm(float v, int srclane) { return __int_as_float(__builtin_amdgcn_ds_bpermute(srclane << 2, __float_as_int(v))); }
#define MFMA16(a, b, c) __builtin_amdgcn_mfma_f32_16x16x32_bf16((a), (b), (c), 0, 0, 0)

template <int MODE>
DEVI void hgrn_wave_block(const Params& p, const float* __restrict__ P, float* KS, const int l, const int b, const int h, const int dir, const int n, const int lane,
                          f32x4 (&S)[4][4], float (&dsum)[4][4]) {
  const int fr = lane & 15, fq = lane >> 4;
  const int zb = (dir ? 768 : 512) + h * 64 + 4 * fq;
  float* OF = (float*)(p.ws + OFF_YS + (8u << 20));
  float lbv[4][4];
#pragma unroll
  for (int m = 0; m < 4; ++m) { const float4 t = *(const float4*)((const float*)(p.ws + OFF_LB) + (l * 2 + dir) * 256 + h * 64 + 16 * m + 4 * fq); lbv[m][0] = t.x; lbv[m][1] = t.y; lbv[m][2] = t.z; lbv[m][3] = t.w; }
#pragma unroll 1
  for (int c4 = 0; c4 < 4; ++c4) {
    const int i0 = 64 * n + 16 * c4;
    const size_t rt = (size_t)seq_row(b, dir, i0 + fr);
    float z[4][4], q[4][4], vv[4][4];
#pragma unroll
    for (int m = 0; m < 4; ++m) {
      const float4 t = *(const float4*)(P + rt * DIN + zb + 16 * m); z[m][0] = t.x; z[m][1] = t.y; z[m][2] = t.z; z[m][3] = t.w;
      if (MODE != 0) { const float4 u = *(const float4*)(P + rt * DIN + h * 64 + 16 * m + 4 * fq); q[m][0] = u.x; q[m][1] = u.y; q[m][2] = u.z; q[m][3] = u.w; }
    }
#pragma unroll
    for (int j = 0; j < 4; ++j) {
      const size_t rs = (size_t)seq_row(b, dir, i0 + 4 * fq + j);
#pragma unroll
      for (int nt = 0; nt < 4; ++nt) vv[nt][j] = P[rs * DIN + 256 + h * 64 + 16 * nt + fr];
    }
    float Qh[4][4], Kh[4][4], dec[4][4];
#pragma unroll
    for (int m = 0; m < 4; ++m) {
      float ku[4];
#pragma unroll
      for (int j = 0; j < 4; ++j) {
        const float zc = fminf(fmaxf(z[m][j], -80.f), 80.f);
        const float e1 = __expf(-zc), sig = __builtin_amdgcn_rcpf(1.f + e1);
        const float lb = lbv[m][j];
        const float lf = __logf(lb + (1.f - lb) * sig);
        const float kk = (1.f - lb) * e1 * sig;
        float B = lf;
        B += dppz<0x111>(B); B += dppz<0x112>(B); B += dppz<0x114>(B); B += dppz<0x118>(B);
        const float bs = bperm(B, lane | 15);
        const float Bc = fmaxf(B, -80.f);
        const float eB = __expf(Bc);
        Kh[m][j] = kk * __builtin_amdgcn_rcpf(eB);
        if (MODE != 0) Qh[m][j] = q[m][j] * __builtin_amdgcn_rcpf(1.f + __expf(-q[m][j])) * eB;
        dec[m][j] = __expf(bs);
        ku[j] = Kh[m][j] * dec[m][j];
        if (MODE == 0) dsum[m][j] += bs;
      }
      *(float4*)(KS + fr * 68 + 16 * m + 4 * fq) = make_float4(ku[0], ku[1], ku[2], ku[3]);
    }
    __builtin_amdgcn_fence(__ATOMIC_ACQ_REL, "wavefront"); __builtin_amdgcn_wave_barrier();
    bf16x8 KuTf[4], Vf[4];
#pragma unroll
    for (int mt = 0; mt < 4; ++mt) {
      const float a0 = KS[(4 * fq + 0) * 68 + 16 * mt + fr], a1 = KS[(4 * fq + 1) * 68 + 16 * mt + fr], a2 = KS[(4 * fq + 2) * 68 + 16 * mt + fr], a3 = KS[(4 * fq + 3) * 68 + 16 * mt + fr];
      KuTf[mt] = pk8(a0, a1, a2, a3, 0.f, 0.f, 0.f, 0.f);
      Vf[mt] = pk8(vv[mt][0], vv[mt][1], vv[mt][2], vv[mt][3], 0.f, 0.f, 0.f, 0.f);
    }
    __builtin_amdgcn_fence(__ATOMIC_ACQ_REL, "wavefront"); __builtin_amdgcn_wave_barrier();
    if (MODE != 0) {
      bf16x8 Qf[2], Kf[2];
#pragma unroll
      for (int ks = 0; ks < 2; ++ks) {
        Qf[ks] = pk8(Qh[2 * ks][0], Qh[2 * ks][1], Qh[2 * ks][2], Qh[2 * ks][3], Qh[2 * ks + 1][0], Qh[2 * ks + 1][1], Qh[2 * ks + 1][2], Qh[2 * ks + 1][3]);
        Kf[ks] = pk8(Kh[2 * ks][0], Kh[2 * ks][1], Kh[2 * ks][2], Kh[2 * ks][3], Kh[2 * ks + 1][0], Kh[2 * ks + 1][1], Kh[2 * ks + 1][2], Kh[2 * ks + 1][3]);
      }
      f32x4 sc = f32x4{0.f, 0.f, 0.f, 0.f};
      sc = MFMA16(Kf[0], Qf[0], sc); sc = MFMA16(Kf[1], Qf[1], sc);
      const bf16x8 Pf = pk8((4 * fq + 0 <= fr) ? sc[0] : 0.f, (4 * fq + 1 <= fr) ? sc[1] : 0.f, (4 * fq + 2 <= fr) ? sc[2] : 0.f, (4 * fq + 3 <= fr) ? sc[3] : 0.f, 0.f, 0.f, 0.f, 0.f);
      f32x4 O[4];
#pragma unroll
      for (int mt = 0; mt < 4; ++mt) {
        f32x4 o = f32x4{0.f, 0.f, 0.f, 0.f};
#pragma unroll
        for (int ks = 0; ks < 2; ++ks) {
          const bf16x8 Sf = pk8(S[2 * ks][mt][0], S[2 * ks][mt][1], S[2 * ks][mt][2], S[2 * ks][mt][3], S[2 * ks + 1][mt][0], S[2 * ks + 1][mt][1], S[2 * ks + 1][mt][2], S[2 * ks + 1][mt][3]);
          o = MFMA16(Sf, Qf[ks], o);
        }
        O[mt] = MFMA16(Vf[mt], Pf, o);
      }
      if (MODE == 1) {
#pragma unroll
        for (int mt = 0; mt < 4; ++mt) *(float4*)(OF + rt * 256 + h * 64 + 16 * mt + 4 * fq) = make_float4(O[mt][0], O[mt][1], O[mt][2], O[mt][3]);
      } else {
        float ss = 0.f;
#pragma unroll
        for (int mt = 0; mt < 4; ++mt) { const float4 of = *(const float4*)(OF + rt * 256 + h * 64 + 16 * mt + 4 * fq);
          O[mt][0] += of.x; O[mt][1] += of.y; O[mt][2] += of.z; O[mt][3] += of.w;
          ss += O[mt][0] * O[mt][0] + O[mt][1] * O[mt][1] + O[mt][2] * O[mt][2] + O[mt][3] * O[mt][3]; }
        ss += bperm(ss, lane ^ 16); ss += bperm(ss, lane ^ 32);
        const float rstd = rsqrtf(ss * (1.f / 64.f) + 1e-6f);
        bf16_t* MIX = (bf16_t*)(p.ws + OFF_MIX);
#pragma unroll
        for (int mt = 0; mt < 4; ++mt) {
          const float4 gg = *(const float4*)(P + rt * DIN + 1024 + h * 64 + 16 * mt + 4 * fq);
          const float4 hg = *(const float4*)(p.hnorm_g + l * 256 + h * 64 + 16 * mt + 4 * fq);
          s16x4 o;
          o[0] = (short)f2bf(O[mt][0] * rstd * hg.x * silu_f(gg.x)); o[1] = (short)f2bf(O[mt][1] * rstd * hg.y * silu_f(gg.y));
          o[2] = (short)f2bf(O[mt][2] * rstd * hg.z * silu_f(gg.z)); o[3] = (short)f2bf(O[mt][3] * rstd * hg.w * silu_f(gg.w));
          *(s16x4*)(MIX + rt * 1024 + h * 64 + 16 * mt + 4 * fq) = o;
        }
      }
    }
#pragma unroll
    for (int mtk = 0; mtk < 4; ++mtk)
#pragma unroll
      for (int ntv = 0; ntv < 4; ++ntv) {
        f32x4 s = S[mtk][ntv];
        s[0] *= dec[mtk][0]; s[1] *= dec[mtk][1]; s[2] *= dec[mtk][2]; s[3] *= dec[mtk][3];
        S[mtk][ntv] = MFMA16(KuTf[mtk], Vf[ntv], s);
      }
  }
}

DEVI void hgrn_load_S(const float* __restrict__ HU, const int lane_off, f32x4 (&S)[4][4]) {
#pragma unroll
  for (int mtk = 0; mtk < 4; ++mtk) {
    int off = lane_off + mtk * 1024; asm volatile("" : "+v"(off));
    const float* pm = HU + off;
#pragma unroll
    for (int ntv = 0; ntv < 4; ++ntv)
#pragma unroll
      for (int j = 0; j < 4; ++j) S[mtk][ntv][j] = pm[j * 64 + 16 * ntv];
  }
}
DEVI void hgrn_store_S(float* __restrict__ HU, const int lane_off, const f32x4 (&S)[4][4]) {
#pragma unroll
  for (int mtk = 0; mtk < 4; ++mtk) {
    int off = lane_off + mtk * 1024; asm volatile("" : "+v"(off));
    float* pm = HU + off;
#pragma unroll
    for (int ntv = 0; ntv < 4; ++ntv)
#pragma unroll
      for (int j = 0; j < 4; ++j) pm[j * 64 + 16 * ntv] = S[mtk][ntv][j];
  }
}
DEVI void hgrn_local_task(const Params& p, int l, int task, int lane, float* KS) {
  const int seq = task / 36, n = task % 36, b = seq >> 3, h = (seq >> 1) & 3, dir = seq & 1, fr = lane & 15, fq = lane >> 4;
  f32x4 S[4][4]; float dsum[4][4];
#pragma unroll
  for (int a = 0; a < 4; ++a)
#pragma unroll
    for (int c = 0; c < 4; ++c) { S[a][c] = f32x4{0.f, 0.f, 0.f, 0.f}; dsum[a][c] = 0.f; }
  hgrn_wave_block<0>(p, (const float*)(p.ws + OFF_P), KS, l, b, h, dir, n, lane, S, dsum);
  hgrn_store_S((float*)(p.ws + OFF_OA) + (size_t)(seq * 36 + n) * 4096, 4 * fq * 64 + fr, S);
  if (fr == 0) {
    float* HD = (float*)(p.ws + OFF_YS) + (seq * 36 + n) * 64;
#pragma unroll
    for (int m = 0; m < 4; ++m)
#pragma unroll
      for (int j = 0; j < 4; ++j) HD[16 * m + 4 * fq + j] = __expf(dsum[m][j]);
  }
}
DEVI void hgrn_out_task(const Params& p, int l, int task, int lane, float* KS) {
  const int b = task / 144, h = (task / 36) & 3, nf = task % 36, fr = lane & 15, fq = lane >> 4;
  if (l == 3 && nf < 4) return;
  const float* P = (const float*)(p.ws + OFF_P);
  f32x4 S[4][4]; float dsum[4][4];
  hgrn_load_S((const float*)(p.ws + OFF_OA) + (size_t)(((b * 4 + h) * 2 + 0) * 36 + nf) * 4096, 4 * fq * 64 + fr, S);
  hgrn_wave_block<1>(p, P, KS, l, b, h, 0, nf, lane, S, dsum);
  asm volatile("s_waitcnt vmcnt(0)" ::: "memory");
  __builtin_amdgcn_fence(__ATOMIC_ACQUIRE, "agent");
  hgrn_load_S((const float*)(p.ws + OFF_OA) + (size_t)(((b * 4 + h) * 2 + 1) * 36 + mirror_blk(nf)) * 4096, 4 * fq * 64 + fr, S);
  hgrn_wave_block<2>(p, P, KS, l, b, h, 1, mirror_blk(nf), lane, S, dsum);
}

__device__ void hgrn_scan_item(const Params& p, int j) {
  int tid = threadIdx.x; asm volatile("" : "+v"(tid));
  const int seq = j >> 3, el = (j & 7) * 512 + tid, k = el >> 6;
  float* HU = (float*)(p.ws + OFF_OA) + (size_t)seq * 36 * 4096 + el;
  const float* HD = (const float*)(p.ws + OFF_YS) + seq * 36 * 64 + k;
  float s = 0.f;
#pragma unroll 6
  for (int n = 0; n < 36; ++n) { const float u = HU[(size_t)n * 4096]; const float d = HD[n * 64]; HU[(size_t)n * 4096] = s; s = d * s + u; }
}
DEVI int crow(int i, int h) { return (i & 3) + 8 * (i >> 2) + 4 * h; }
DEVI void split8(const float4 a, const float4 b, const float sgn, bf16x8& hi, bf16x8& lo) {
  const float v[8] = {a.x, a.y, a.z, a.w, b.x, b.y, b.z, b.w};
#pragma unroll
  for (int j = 0; j < 8; ++j) { const float x = sgn * v[j]; const unsigned short hh = f2bf(x); hi[j] = (short)hh; lo[j] = (short)f2bf(x - __uint_as_float((unsigned)hh << 16)); }
}
DEVI int sphys(int t, int col) { return t * 128 + ((((col >> 2) ^ (t & 7)) << 2) | (col & 3)); }

template <int MODE>
DEVI void s5_wave_dir(const Params& p, const float* __restrict__ P, float* SB, const int l, const int b, const int g, const int dir, const int n, const int lane, float& hr, float& hi, f32x4 (&Y)[4]) {
  const int e = (l * 2 + dir) * 16 + g;
  const int r = lane & 31, h = lane >> 5, fr = lane & 15, fq = lane >> 4;
  const float ar = ((const float*)(p.ws + OFF_ABAR))[(e * 64 + lane) * 2], ai = ((const float*)(p.ws + OFF_ABAR))[(e * 64 + lane) * 2 + 1];
  bf16x8 bh[4], bl[4];
#pragma unroll
  for (int nt = 0; nt < 4; ++nt) {
    const int n_ = 32 * nt + r, ri = n_ >> 6, pq = n_ & 63;
    const float* bp = (const float*)(p.ws + OFF_BBAR) + ((size_t)((e * 2 + ri) * 64 + pq)) * 16 + 8 * h;
    split8(*(const float4*)bp, *(const float4*)(bp + 4), 1.f, bh[nt], bl[nt]);
  }
  bf16x8 chh[4], chl[4];
  if (MODE == 1) {
#pragma unroll
    for (int ks = 0; ks < 4; ++ks) {
      const float* cp = ((ks < 2) ? p.c_re : p.c_im) + (size_t)e * 1024 + fr * 64 + (ks & 1) * 32 + fq * 8;
      split8(*(const float4*)cp, *(const float4*)(cp + 4), (ks < 2) ? 1.f : -1.f, chh[ks], chl[ks]);
    }
  }
  float4 ur[2][2];
#pragma unroll
  for (int hb = 0; hb < 2; ++hb) { const float* up = P + (size_t)seq_row(b, dir, 64 * n + 32 * hb + r) * DIN + 2048 + g * 16 + 8 * h; ur[hb][0] = *(const float4*)up; ur[hb][1] = *(const float4*)(up + 4); }
#pragma unroll
  for (int hb = 0; hb < 2; ++hb) {
    { bf16x8 uh, ul; split8(ur[hb][0], ur[hb][1], 1.f, uh, ul);
#pragma unroll
      for (int nt = 0; nt < 4; ++nt) {
        f32x16 x;
#pragma unroll
        for (int i = 0; i < 16; ++i) x[i] = 0.f;
        x = __builtin_amdgcn_mfma_f32_32x32x16_bf16(uh, bh[nt], x, 0, 0, 0);
        x = __builtin_amdgcn_mfma_f32_32x32x16_bf16(uh, bl[nt], x, 0, 0, 0);
        x = __builtin_amdgcn_mfma_f32_32x32x16_bf16(ul, bh[nt], x, 0, 0, 0);
#pragma unroll
        for (int i = 0; i < 16; ++i) SB[sphys(crow(i, h), 32 * nt + r)] = x[i];
      } }
    __builtin_amdgcn_fence(__ATOMIC_ACQ_REL, "wavefront"); __builtin_amdgcn_wave_barrier();
#pragma unroll
    for (int tb = 0; tb < 32; tb += 16) {
      float sre[16], sim[16];
#pragma unroll
      for (int t = 0; t < 16; ++t) { sre[t] = SB[sphys(tb + t, lane)]; sim[t] = SB[sphys(tb + t, 64 + lane)]; }
#pragma unroll
      for (int t = 0; t < 16; ++t) {
        const float nr = ar * hr - ai * hi + sre[t], ni = ar * hi + ai * hr + sim[t];
        hr = nr; hi = ni; sre[t] = hr; sim[t] = hi;
      }
      if (MODE == 1) {
#pragma unroll
        for (int t = 0; t < 16; ++t) { SB[sphys(tb + t, lane)] = sre[t]; SB[sphys(tb + t, 64 + lane)] = sim[t]; }
      }
    }
    __builtin_amdgcn_fence(__ATOMIC_ACQ_REL, "wavefront"); __builtin_amdgcn_wave_barrier();
    if (MODE == 1) {
#pragma unroll
      for (int m2 = 0; m2 < 2; ++m2) {
        const int trow = 16 * m2 + (dir ? 15 - fr : fr);
#pragma unroll
        for (int ks = 0; ks < 4; ++ks) {
          const int c0 = ks * 32 + fq * 8;
          const float4 h0 = *(const float4*)(SB + sphys(trow, c0)), h1 = *(const float4*)(SB + sphys(trow, c0 + 4));
          const bf16x8 ah = pk8(h0.x, h0.y, h0.z, h0.w, h1.x, h1.y, h1.z, h1.w);
          Y[2 * hb + m2] = __builtin_amdgcn_mfma_f32_16x16x32_bf16(ah, chh[ks], Y[2 * hb + m2], 0, 0, 0);
          Y[2 * hb + m2] = __builtin_amdgcn_mfma_f32_16x16x32_bf16(ah, chl[ks], Y[2 * hb + m2], 0, 0, 0);
        }
      }
      __builtin_amdgcn_fence(__ATOMIC_ACQ_REL, "wavefront"); __builtin_amdgcn_wave_barrier();
    }
  }
}

DEVI void s5_local_task(const Params& p, int l, int t, int lane, float* SB) {
  const int g = t & 15, n = (t >> 4) % 36, bd = (t >> 4) / 36, dir = bd & 1, b = bd >> 1;
  float hr = 0.f, hi = 0.f; f32x4 Y[4];
  s5_wave_dir<0>(p, (const float*)(p.ws + OFF_P), SB, l, b, g, dir, n, lane, hr, hi, Y);
  float2* SE = (float2*)(p.ws + OFF_YS + (1u << 20));
  SE[((size_t)((b * 16 + g) * 2 + dir) * 36 + n) * 64 + lane] = make_float2(hr, hi);
}
DEVI void s5_out_task(const Params& p, int l, int t, int lane, float* SB) {
  const int g = t & 15, nf = (t >> 4) % 36, b = (t >> 4) / 36, fr = lane & 15, fq = lane >> 4;
  if (l == 3 && nf < 4) return;
  const float* P = (const float*)(p.ws + OFF_P);
  f32x4 Y[4];
#pragma unroll
  for (int i = 0; i < 4; ++i) Y[i] = f32x4{0.f, 0.f, 0.f, 0.f};
#pragma unroll 1
  for (int dir = 0; dir < 2; ++dir) {
    const int n = dir ? mirror_blk(nf) : nf;
    const float2 cin = ((const float2*)(p.ws + OFF_YS + (1u << 20)))[((size_t)((b * 16 + g) * 2 + dir) * 36 + n) * 64 + lane];
    float hr = cin.x, hi = cin.y;
    s5_wave_dir<1>(p, P, SB, l, b, g, dir, n, lane, hr, hi, Y);
    { const f32x4 t0 = Y[0], t1 = Y[1]; Y[0] = Y[3]; Y[1] = Y[2]; Y[2] = t1; Y[3] = t0; }
  }
  const float dv = p.s5_d[l * 256 + g * 16 + fr];
  bf16_t* GA = (bf16_t*)(p.ws + OFF_GA);
#pragma unroll
  for (int mt = 0; mt < 4; ++mt)
#pragma unroll
    for (int j = 0; j < 4; ++j) {
      const int tl = 16 * mt + fq * 4 + j;
      const size_t row = (size_t)seq_row(b, 0, nf * 64 + tl);
      const float u = P[row * DIN + 2048 + g * 16 + fr];
      const float t2 = Y[mt][j] + dv * u;
      GA[row * 256 + g * 16 + fr] = f2bf(t2 * __builtin_amdgcn_rcpf(1.f + __expf(-1.5957691216057308f * (t2 + 0.044715f * t2 * t2 * t2))));
    }
}

__device__ void attn_item(const Params& p, int l, int a) {
  extern __shared__ __attribute__((aligned(16))) unsigned char lds_raw[];
  bf16_t* Ks = (bf16_t*)lds_raw;
  bf16_t* Vt = (bf16_t*)(lds_raw + 128 * 72 * 2);
  const float* P = (const float*)(p.ws + OFF_P);
  const float* RC = (const float*)(p.ws + OFF_ROPE); const float* RS = RC + 1024;
  bf16_t* MIX = (bf16_t*)(p.ws + OFF_MIX);
  int tid = threadIdx.x; asm volatile("" : "+v"(tid));
  const int lane = tid & 63, w = tid >> 6, r = lane & 31, h = lane >> 5;
  const bool lat = a < 512;
  int b, hk, n = 0, t0, qrow0;
  if (lat) { b = a >> 6; const int rem = a & 63; n = rem >> 2; hk = (rem >> 1) & 1; t0 = n * 128 + (rem & 1) * 64; qrow0 = b * 2048 + t0; }
  else { const int c = a - 512; b = c >> 3; hk = (c >> 2) & 1; t0 = (c & 3) * 64; qrow0 = NLAT + b * 256 + t0; }
  const int g = w >> 1, qsub = w & 1, tq = t0 + qsub * 32 + r, qrow = qrow0 + qsub * 32 + r, hq = hk * 4 + g;
  bf16x8 qf[4];
  { const float* qp = P + (size_t)qrow * DIN + 1280 + hq * 64;
#pragma unroll
    for (int a2 = 0; a2 < 2; ++a2) {
      float x1[8], x2[8];
      { const float4 u0 = *(const float4*)(qp + a2 * 32 + 8 * h), u1 = *(const float4*)(qp + a2 * 32 + 8 * h + 4);
        const float4 w0 = *(const float4*)(qp + a2 * 32 + 16 + 8 * h), w1 = *(const float4*)(qp + a2 * 32 + 16 + 8 * h + 4);
        x1[0] = u0.x; x1[1] = u0.y; x1[2] = u0.z; x1[3] = u0.w; x1[4] = u1.x; x1[5] = u1.y; x1[6] = u1.z; x1[7] = u1.w;
        x2[0] = w0.x; x2[1] = w0.y; x2[2] = w0.z; x2[3] = w0.w; x2[4] = w1.x; x2[5] = w1.y; x2[6] = w1.z; x2[7] = w1.w; }
      const int pos = (a2 == 0) ? (tq >> 6) : (tq & 63);
      float cs[8], sn[8];
      { const float4 c0 = *(const float4*)(RC + pos * 16 + 8 * h), c1 = *(const float4*)(RC + pos * 16 + 8 * h + 4);
        const float4 s0 = *(const float4*)(RS + pos * 16 + 8 * h), s1 = *(const float4*)(RS + pos * 16 + 8 * h + 4);
        cs[0] = c0.x; cs[1] = c0.y; cs[2] = c0.z; cs[3] = c0.w; cs[4] = c1.x; cs[5] = c1.y; cs[6] = c1.z; cs[7] = c1.w;
        sn[0] = s0.x; sn[1] = s0.y; sn[2] = s0.z; sn[3] = s0.w; sn[4] = s1.x; sn[5] = s1.y; sn[6] = s1.z; sn[7] = s1.w; }
#pragma unroll
      for (int j = 0; j < 8; ++j) {
        const float c = lat ? cs[j] : 1.f, sv = lat ? sn[j] : 0.f;
        const float o1 = x1[j] * c - x2[j] * sv, o2 = x2[j] * c + x1[j] * sv;
        qf[2 * a2][j] = (short)f2bf(o1 * 0.18033688f); qf[2 * a2 + 1][j] = (short)f2bf(o2 * 0.18033688f);
      }
    } }
  const float sinkv = p.sink[l * 8 + hq] * 1.44269504f;
  float mrun = sinkv, lsum = 0.5f;
  f32x16 O0, O1;
#pragma unroll
  for (int i = 0; i < 16; ++i) { O0[i] = 0.f; O1[i] = 0.f; }
  for (int blk = 0; blk < 5; ++blk) {
    bool kl; int kb;
    if (blk < 3) { if (!lat) continue; kb = n - 1 + blk; if (kb < 0 || kb > 15) continue; kl = true; }
    else { kl = false; kb = blk - 3; }
    __syncthreads();
    {
      const int key = tid >> 2, qd = tid & 3, a2 = qd >> 1, i0 = (qd & 1) * 8;
      const int s = kb * 128 + key;
      const size_t krow = kl ? (size_t)(b * 2048 + s) : (size_t)(NLAT + b * 256 + s);
      const float* kp = P + krow * DIN + 1792 + hk * 64;
      float x1[8], x2[8];
      { const float4 u0 = *(const float4*)(kp + a2 * 32 + i0), u1 = *(const float4*)(kp + a2 * 32 + i0 + 4);
        const float4 w0 = *(const float4*)(kp + a2 * 32 + 16 + i0), w1 = *(const float4*)(kp + a2 * 32 + 16 + i0 + 4);
        x1[0] = u0.x; x1[1] = u0.y; x1[2] = u0.z; x1[3] = u0.w; x1[4] = u1.x; x1[5] = u1.y; x1[6] = u1.z; x1[7] = u1.w;
        x2[0] = w0.x; x2[1] = w0.y; x2[2] = w0.z; x2[3] = w0.w; x2[4] = w1.x; x2[5] = w1.y; x2[6] = w1.z; x2[7] = w1.w; }
      const int pos = (a2 == 0) ? (s >> 6) : (s & 63);
      float cs[8], sn[8];
      { const float4 c0 = *(const float4*)(RC + pos * 16 + i0), c1 = *(const float4*)(RC + pos * 16 + i0 + 4);
        const float4 s0 = *(const float4*)(RS + pos * 16 + i0), s1 = *(const float4*)(RS + pos * 16 + i0 + 4);
        cs[0] = c0.x; cs[1] = c0.y; cs[2] = c0.z; cs[3] = c0.w; cs[4] = c1.x; cs[5] = c1.y; cs[6] = c1.z; cs[7] = c1.w;
        sn[0] = s0.x; sn[1] = s0.y; sn[2] = s0.z; sn[3] = s0.w; sn[4] = s1.x; sn[5] = s1.y; sn[6] = s1.z; sn[7] = s1.w; }
      bf16x8 o1v, o2v;
#pragma unroll
      for (int j = 0; j < 8; ++j) {
        const float c = kl ? cs[j] : 1.f, sv = kl ? sn[j] : 0.f;
        o1v[j] = (short)f2bf(x1[j] * c - x2[j] * sv); o2v[j] = (short)f2bf(x2[j] * c + x1[j] * sv);
      }
      *(bf16x8*)(Ks + key * 72 + a2 * 32 + i0) = o1v; *(bf16x8*)(Ks + key * 72 + a2 * 32 + 16 + i0) = o2v;
      const float* vp = P + krow * DIN + 1920 + hk * 64 + qd * 16;
#pragma unroll
      for (int q = 0; q < 4; ++q) { const float4 v = *(const float4*)(vp + q * 4);
        Vt[(qd * 16 + q * 4 + 0) * 132 + key] = f2bf(v.x); Vt[(qd * 16 + q * 4 + 1) * 132 + key] = f2bf(v.y);
        Vt[(qd * 16 + q * 4 + 2) * 132 + key] = f2bf(v.z); Vt[(qd * 16 + q * 4 + 3) * 132 + key] = f2bf(v.w); }
    }
    __syncthreads();
#pragma unroll 1
    for (int kt = 0; kt < 4; ++kt) {
      if (kl && ((kb == n - 1 && (t0 & 64) && kt < 2) || (kb == n + 1 && !(t0 & 64) && kt >= 2))) continue;
      f32x16 xs;
#pragma unroll
      for (int i = 0; i < 16; ++i) xs[i] = 0.f;
#pragma unroll
      for (int ds = 0; ds < 4; ++ds) { const bf16x8 kf = *(const bf16x8*)(Ks + (kt * 32 + r) * 72 + ds * 16 + 8 * h); xs = __builtin_amdgcn_mfma_f32_32x32x16_bf16(kf, qf[ds], xs, 0, 0, 0); }
      if (kl && kb != n) {
        const int sb = kb * 128 + kt * 32;
#pragma unroll
        for (int i = 0; i < 16; ++i) { const int d = tq - (sb + crow(i, h)); if (d > 128 || d < -128) xs[i] = -1e9f; }
      }
      float tmax = xs[0];
#pragma unroll
      for (int i = 1; i < 16; ++i) tmax = fmaxf(tmax, xs[i]);
      tmax = fmaxf(tmax, shx(tmax, 32, lane));
      if (__builtin_amdgcn_ballot_w64(tmax - mrun > 8.f) != 0ull) {
        const float mnew = fmaxf(mrun, tmax), alpha = __builtin_amdgcn_exp2f(mrun - mnew);
        mrun = mnew; lsum *= alpha;
#pragma unroll
        for (int i = 0; i < 16; ++i) { O0[i] *= alpha; O1[i] *= alpha; }
      }
      float pv[16], psum = 0.f;
#pragma unroll
      for (int i = 0; i < 16; ++i) { pv[i] = __builtin_amdgcn_exp2f(xs[i] - mrun); psum += pv[i]; }
      lsum += psum;
#pragma unroll
      for (int s2 = 0; s2 < 2; ++s2) {
        bf16x8 ps;
#pragma unroll
        for (int j = 0; j < 8; ++j) ps[j] = (short)f2bf(pv[8 * s2 + j]);
        { const bf16_t* vp = Vt + (r) * 132 + kt * 32 + 16 * s2 + 4 * h; const s16x4 lo = *(const s16x4*)vp, hi2 = *(const s16x4*)(vp + 8);
          const bf16x8 va = __builtin_shufflevector(lo, hi2, 0, 1, 2, 3, 4, 5, 6, 7); O0 = __builtin_amdgcn_mfma_f32_32x32x16_bf16(va, ps, O0, 0, 0, 0); }
        { const bf16_t* vp = Vt + (32 + r) * 132 + kt * 32 + 16 * s2 + 4 * h; const s16x4 lo = *(const s16x4*)vp, hi2 = *(const s16x4*)(vp + 8);
          const bf16x8 va = __builtin_shufflevector(lo, hi2, 0, 1, 2, 3, 4, 5, 6, 7); O1 = __builtin_amdgcn_mfma_f32_32x32x16_bf16(va, ps, O1, 0, 0, 0); }
      }
    }
  }
  const float inv = 1.f / (lsum + shx(lsum, 32, lane));
  bf16_t* op = MIX + (size_t)qrow * 1024 + 256 + hq * 64;
#pragma unroll
  for (int gq = 0; gq < 4; ++gq) {
    s16x4 o0, o1;
#pragma unroll
    for (int j = 0; j < 4; ++j) { o0[j] = (short)f2bf(O0[gq * 4 + j] * inv); o1[j] = (short)f2bf(O1[gq * 4 + j] * inv); }
    *(s16x4*)(op + 8 * gq + 4 * h) = o0; *(s16x4*)(op + 32 + 8 * gq + 4 * h) = o1;
  }
  __syncthreads();
}

#define QUEUE_LOOP(CNT, NITEMS, BODY) do { \
    extern __shared__ __attribute__((aligned(16))) unsigned char lds_raw[]; \
    int* slot_ = (int*)(lds_raw + 131072); int* cnt_ = (CNT); const int nit_ = (NITEMS); \
    __syncthreads(); if (threadIdx.x == 0) *slot_ = atomicAdd(cnt_, 1); __syncthreads(); \
    int it = *slot_; \
    while (it < nit_) { \
      int nxt_ = 0; if (threadIdx.x == 0) nxt_ = atomicAdd(cnt_, 1); \
      BODY \
      if (threadIdx.x == 0) *slot_ = nxt_; __syncthreads(); it = *slot_; __syncthreads(); \
    } } while (0)

__device__ void s5_carry_item(const Params& p, int l, int j) {
  int tid = threadIdx.x; asm volatile("" : "+v"(tid));
  const int lane = tid & 63, q = j * 8 + (tid >> 6), dir = q & 1, g = (q >> 1) & 15;
  const int e = (l * 2 + dir) * 16 + g;
  float pr = ((const float*)(p.ws + OFF_ABAR))[(e * 64 + lane) * 2], pi = ((const float*)(p.ws + OFF_ABAR))[(e * 64 + lane) * 2 + 1];
#pragma unroll
  for (int s = 0; s < 6; ++s) { const float t = pr * pr - pi * pi; pi = 2.f * pr * pi; pr = t; }
  float2* SE = (float2*)(p.ws + OFF_YS + (1u << 20)) + (size_t)q * 36 * 64 + lane;
  float hr = 0.f, hi = 0.f;
#pragma unroll 6
  for (int m = 0; m < 36; ++m) { const float2 ev = SE[m * 64]; SE[m * 64] = make_float2(hr, hi); const float t = pr * hr - pi * hi + ev.x; hi = pr * hi + pi * hr + ev.y; hr = t; }
}
__device__ void phase_MA(const Params& p, const Grp gr, int l) {
  extern __shared__ __attribute__((aligned(16))) unsigned char lds_raw[];
  int tid = threadIdx.x; asm volatile("" : "+v"(tid));
  const int lane = tid & 63, w = __builtin_amdgcn_readfirstlane(tid >> 6);
  const int NS = 8 * gr.nloc, s = w * gr.nloc + gr.rank;
  float* LW = (float*)lds_raw + w * 4096;
  const int nbg = (8 - gr.gi + gr.nx - 1) / gr.nx;
#pragma unroll 1
  for (int v = s; v < nbg * 288; v += NS) hgrn_local_task(p, l, 288 * (gr.gi + (v / 288) * gr.nx) + v % 288, lane, LW);
#pragma unroll 1
  for (int v = NS - 1 - s; v < nbg * 1152; v += NS) s5_local_task(p, l, 1152 * (gr.gi + (v / 1152) * gr.nx) + v % 1152, lane, LW);
}
__device__ void phase_MB(const Params& p, const Grp gr, int l) {
  const int nctx = (l < 3) ? 8 : 0;
  for (int b = gr.gi; b < 8; b += gr.nx) {
    QUEUE_LOOP((int*)(p.ws + OFF_CNT) + l * 8 + b, 64 + nctx + 64 + 4,
      if (it < 64) attn_item(p, l, b * 64 + it); else if (it < 64 + nctx) attn_item(p, l, 512 + b * 8 + (it - 64));
      else if (it < 128 + nctx) { hgrn_scan_item(p, b * 64 + (it - 64 - nctx)); __syncthreads(); } else { s5_carry_item(p, l, b * 4 + (it - 128 - nctx)); __syncthreads(); } );
  }
}
__device__ void phase_MC(const Params& p, const Grp gr, int l) {
  extern __shared__ __attribute__((aligned(16))) unsigned char lds_raw[];
  int tid = threadIdx.x; asm volatile("" : "+v"(tid));
  const int lane = tid & 63, w = __builtin_amdgcn_readfirstlane(tid >> 6);
  const int NS = 8 * gr.nloc, s = w * gr.nloc + gr.rank;
  float* LW = (float*)lds_raw + w * 4096;
  const int nbg = (8 - gr.gi + gr.nx - 1) / gr.nx;
#pragma unroll 1
  for (int v = s; v < nbg * 144; v += NS) hgrn_out_task(p, l, 144 * (gr.gi + (v / 144) * gr.nx) + v % 144, lane, LW);
#pragma unroll 1
  for (int v = NS - 1 - s; v < nbg * 576; v += NS) s5_out_task(p, l, 576 * (gr.gi + (v / 576) * gr.nx) + v % 576, lane, LW);
}

#define XB_TMO      128
#define XB_XCNT(j)  (256  + 64 * (j))
#define XB_XSUB(j)  (1280 + 64 * (j))
#define XB_XGEN(j)  (2304 + 64 * (j))
#define XB_TOP      3328
#define XB_TOPGEN   3392
#define XB_LSUB(j)  (3456 + 64 * (j))
#define XB_LGEN(j)  (4480 + 64 * (j))
#define XCD_BAR_WORDS 5504
#define XB_SPIN_CAP (1u << 22)
#define LAS __attribute__((address_space(3)))
DEVI unsigned xb_ld(unsigned* p)              { return __hip_atomic_load(p, __ATOMIC_RELAXED, __HIP_MEMORY_SCOPE_AGENT); }
DEVI unsigned xb_add(unsigned* p, unsigned v) { return __hip_atomic_fetch_add(p, v, __ATOMIC_RELAXED, __HIP_MEMORY_SCOPE_AGENT); }
DEVI unsigned xb_xcc_id() { return (unsigned)__builtin_amdgcn_s_getreg((3 << 11) | 20) & 0xFu; }
#define XB_SPIN(cond, bar) do { unsigned _sp = 0; while (cond) { __builtin_amdgcn_s_sleep(1); \
    if ((++_sp & 255u) == 0u) { if (xb_ld(&(bar)[XB_TMO])) break; if (_sp > XB_SPIN_CAP) { atomicAdd(&(bar)[XB_TMO], 1u); break; } } } } while (0)
struct XcdBarrier { unsigned* bar; unsigned x; volatile LAS unsigned* st; };
DEVI XcdBarrier xcd_barrier_post(unsigned* bar, volatile LAS unsigned* st) {
  XcdBarrier b; b.bar = bar; b.x = xb_xcc_id(); b.st = st;
  if (threadIdx.x == 0) st[3] = xb_add(&bar[XB_XCNT(b.x)], 1u);
  return b;
}
DEVI void xcd_barrier_complete(unsigned* bar, unsigned x, unsigned& nloc, unsigned& nx) {
  const unsigned G = gridDim.x * gridDim.y * gridDim.z;
  unsigned sum, cnt, mine, sp = 0u;
  for (;;) {
    sum = 0u; cnt = 0u; mine = 0u;
#pragma unroll
    for (unsigned j = 0; j < 16; ++j) { const unsigned c = xb_ld(&bar[XB_XCNT(j)]); sum += c; cnt += (c > 0u) ? 1u : 0u; mine = (j == x) ? c : mine; }
    if (sum == G) break;
    __builtin_amdgcn_s_sleep(1);
    if ((++sp & 255u) == 0u) { if (xb_ld(&bar[XB_TMO])) break; if (sp > XB_SPIN_CAP) { atomicAdd(&bar[XB_TMO], 1u); break; } }
  }
  nloc = mine > 0u ? mine : 1u; nx = cnt > 0u ? cnt : 1u;
}
DEVI void xcd_barrier(const XcdBarrier& b) {
  asm volatile("s_waitcnt vmcnt(0)" ::: "memory");
  __syncthreads();
  if (threadIdx.x == 0) {
    unsigned* bar = b.bar;
    __builtin_amdgcn_s_waitcnt(0);
    unsigned nloc = b.st[0], nx = b.st[1];
    if (nloc == 0u) { xcd_barrier_complete(bar, b.x, nloc, nx); b.st[0] = nloc; b.st[1] = nx; }
    const unsigned old = xb_add(&bar[XB_XSUB(b.x)], 1u);
    const unsigned gen = old / nloc;
    if (old + 1u == (gen + 1u) * nloc) {
      __builtin_amdgcn_fence(__ATOMIC_RELEASE, "agent");
      asm volatile("s_waitcnt vmcnt(0)" ::: "memory");
      const unsigned og = xb_add(&bar[XB_TOP], 1u);
      const unsigned tg = og / nx;
      if (og + 1u == (tg + 1u) * nx) xb_add(&bar[XB_TOPGEN], 1u);
      else XB_SPIN(xb_ld(&bar[XB_TOPGEN]) == tg, bar);
      __builtin_amdgcn_fence(__ATOMIC_ACQUIRE, "agent");
      xb_add(&bar[XB_XGEN(b.x)], 1u);
      asm volatile("s_waitcnt vmcnt(0)" ::: "memory");
    } else {
      XB_SPIN(xb_ld(&bar[XB_XGEN(b.x)]) == gen, bar);
      __builtin_amdgcn_fence(__ATOMIC_ACQUIRE, "agent");
      asm volatile("s_waitcnt vmcnt(0)" ::: "memory");
    }
  }
  __syncthreads();
}

DEVI void grp_barrier(const XcdBarrier& b) {
  asm volatile("s_waitcnt vmcnt(0)" ::: "memory");
  __syncthreads();
  if (threadIdx.x == 0) {
    unsigned* bar = b.bar;
    __builtin_amdgcn_s_waitcnt(0);
    const unsigned nloc = b.st[0];
    const unsigned old = xb_add(&bar[XB_LSUB(b.x)], 1u);
    const unsigned gen = old / nloc;
    if (old + 1u == (gen + 1u) * nloc) xb_add(&bar[XB_LGEN(b.x)], 1u);
    else XB_SPIN(xb_ld(&bar[XB_LGEN(b.x)]) == gen, bar);
    __builtin_amdgcn_fence(__ATOMIC_ACQUIRE, "agent");
    asm volatile("s_waitcnt vmcnt(0)" ::: "memory");
  }
  __syncthreads();
}

__global__ void __launch_bounds__(NTHR) mega(Params p) {
  cg::grid_group grid = cg::this_grid();
  phase0(p);
  grid.sync();
  extern __shared__ __attribute__((aligned(16))) unsigned char lds_dyn[];
  volatile LAS unsigned* bst = (volatile LAS unsigned*)(lds_dyn + 131072 + 64);
  if (threadIdx.x < 8) bst[threadIdx.x] = 0u;
  __syncthreads();
  const XcdBarrier xbar = xcd_barrier_post((unsigned*)(p.ws + OFF_BAR), bst);
  xcd_barrier(xbar);
  if (threadIdx.x == 0) {
    unsigned gi = 0u, nx = 0u, nloc = 1u;
    for (unsigned j = 0; j < 16; ++j) { const unsigned c = xb_ld((unsigned*)(p.ws + OFF_BAR) + XB_XCNT(j)); if (c) { ++nx; if (j < xbar.x) ++gi; } if (j == xbar.x) nloc = c ? c : 1u; }
    bst[4] = gi; bst[5] = nx ? nx : 1u; bst[6] = nloc;
  }
  __syncthreads();
  Grp gr;
  gr.gi = __builtin_amdgcn_readfirstlane((int)bst[4]); gr.nx = __builtin_amdgcn_readfirstlane((int)bst[5]);
  gr.rank = __builtin_amdgcn_readfirstlane((int)bst[3]); gr.nloc = __builtin_amdgcn_readfirstlane((int)bst[6]);
  for (int l = 0; l < 4; ++l) {
    const int nMpost = (l < 3) ? 72 : 64;
    for (int s = 0; s < 13; ++s) {
      const int nM = (s < 8) ? 72 : nMpost;
      if (s == 0 || s == 3 || s == 10) {
        const float* MODc = (const float*)(p.ws + OFF_MOD) + 8 * 9216 + 2048;
        const float* pend = nullptr; float pc = 0.5f;
        if (s == 0) { if (l > 0) pend = MODc + (size_t)(l - 1) * 9 * 9216 + 2 * 3072; }
        else if (s == 3) pend = MODc + (size_t)l * 9 * 9216;
        else { if (l < 3) { pend = MODc + (size_t)l * 9 * 9216 + 3072; pc = 1.f; } }
        phase_adaln(p, gr, l, s == 10 ? 2 : s / 3, nM * 256, pend, pc, (l == 0 && s == 0) ? p.x : nullptr, (l == 0 && s <= 3) ? p.ctx : nullptr);
      }
      else if (s == 5) phase_MA(p, gr, l);
      else if (s == 6) phase_MB(p, gr, l);
      else if (s == 7) phase_MC(p, gr, l);
      else {
        bf16_t* H = (bf16_t*)(p.ws + OFF_H); bf16_t* ACT = (bf16_t*)(p.ws + OFF_ACT); float* X = (float*)(p.ws + OFF_X);
        bf16_t* MIX = (bf16_t*)(p.ws + OFF_MIX); bf16_t* GA = (bf16_t*)(p.ws + OFF_GA);
        const float* MOD = (const float*)(p.ws + OFF_MOD) + (size_t)l * 9 * 9216;
        int epi, nN, K; const bf16_t* A; const bf16_t* Bt; EpiArgs ea{nullptr, nullptr, nullptr, 0.f, 0, 0, (float*)(p.ws + OFF_PART), (const float*)(p.ws + OFF_X)};
        if (s == 1 || s == 11) { const int f = (s == 11); epi = 1; A = H; Bt = (const bf16_t*)(p.ws + OFF_W1T) + (size_t)(l * 2 + f) * 5632 * 1024; nN = 22; K = 1024; ea.outb = ACT; ea.ldo = DFF; }
        else if (s == 2 || s == 12) { const int f = (s == 12); epi = 2; A = ACT; Bt = (const bf16_t*)(p.ws + OFF_W2T) + (size_t)(l * 2 + f) * 1024 * 2816; nN = 4; K = 2816; ea.outf = X; ea.aux = MOD + (f ? 2 : 0) * 3072 + 2048; ea.coef = 0.5f; ea.ldo = 1024; if (l == 0 && f == 0) ea.xin = p.x; }
        else if (s == 4) { epi = 0; A = H; Bt = (const bf16_t*)(p.ws + OFF_WINT) + (size_t)l * 2304 * 1024; nN = 9; K = 1024; ea.outf = (float*)(p.ws + OFF_P); ea.ldo = DIN; }
        else if (s == 8) { epi = 3; A = GA; Bt = (const bf16_t*)(p.ws + OFF_GLUT) + (size_t)l * 512 * 256; nN = 2; K = 256; ea.outb = MIX; ea.aux = p.glu_b + l * 512; ea.ldo = 1024; ea.coloff = 768; }
        else { epi = 2; A = MIX; Bt = (const bf16_t*)(p.ws + OFF_WOT) + (size_t)l * 1024 * 1024; nN = 4; K = 1024; ea.outf = X; ea.aux = MOD + 1 * 3072 + 2048; ea.coef = 1.f; ea.ldo = 1024; }
        gemm_phase(gr, epi, A, Bt, nM, nN, K, ea);
      }
      grp_barrier(xbar);
    }
  }
  phase_final(p, gr);
}

extern "C" void kernel_launch(void* const* d_in, const int* in_sizes, int n_in, void* d_out, int out_size, void* d_ws, size_t ws_size, hipStream_t stream) {
  static int grid = 0;
  if (grid == 0) {
    int dev = 0, cus = 0, per_cu = 0;
    hipGetDevice(&dev);
    hipDeviceGetAttribute(&cus, hipDeviceAttributeMultiprocessorCount, dev);
    if (hipFuncSetAttribute((const void*)mega, hipFuncAttributeMaxDynamicSharedMemorySize, LDS_BYTES) != hipSuccess) fprintf(stderr, "hipFuncSetAttribute failed\n");
    if (hipOccupancyMaxActiveBlocksPerMultiprocessor(&per_cu, (const void*)mega, NTHR, LDS_BYTES) != hipSuccess || per_cu < 1) { fprintf(stderr, "occupancy query says %d\n", per_cu); per_cu = 1; }
    (void)hipGetLastError();
    if (cus <= 0) cus = 256;
    grid = cus;
    if (ws_size < WS_END) fprintf(stderr, "workspace too small: %zu < %zu\n", ws_size, (size_t)WS_END);
  }
  Params p{};
  const float** pf = (const float**)&p;
  for (int i = 0; i < 25; ++i) pf[i] = (const float*)d_in[i];
  p.out = (float*)d_out; p.ws = (unsigned char*)d_ws;
  void* args[] = {&p};
  hipError_t e = hipLaunchCooperativeKernel((const void*)mega, dim3(grid), dim3(NTHR), args, LDS_BYTES, stream);
  if (e != hipSuccess) fprintf(stderr, "cooperative launch failed: %s (grid %d)\n", hipGetErrorString(e), grid);
}
```

```cpp
#include <hip/hip_runtime.h>
#include <hip/hip_cooperative_groups.h>
#include <cstdio>
namespace cg = cooperative_groups;

typedef unsigned short bf16_t;
typedef short bf16x8 __attribute__((ext_vector_type(8)));
typedef short s16x4 __attribute__((ext_vector_type(4)));
typedef float f32x4 __attribute__((ext_vector_type(4)));
typedef float f32x16 __attribute__((ext_vector_type(16)));
#define DEVI __device__ __forceinline__

constexpr int NLAT = 16384, NCTX = 2048, NROW = 18432, DM = 1024, DFF = 2816, DIN = 2304;
constexpr int NTHR = 512;
constexpr int LDS_BYTES = 131072 + 256;

constexpr size_t OFF_X    = 0;
constexpr size_t OFF_H    = OFF_X    + (size_t)NROW * DM * 4;
constexpr size_t OFF_P    = OFF_H    + (size_t)NROW * DM * 2;
constexpr size_t OFF_MIX  = OFF_P    + (size_t)NROW * DIN * 4;
constexpr size_t OFF_OA   = OFF_MIX  + (size_t)NROW * DM * 2;
constexpr size_t OFF_YS   = OFF_OA   + (size_t)2 * NROW * 256 * 4;
constexpr size_t OFF_GA   = OFF_YS   + (size_t)2 * NROW * 256 * 4;
constexpr size_t OFF_W1T  = OFF_GA   + (size_t)NROW * 256 * 2;
constexpr size_t OFF_W2T  = OFF_W1T  + (size_t)8 * 5632 * 1024 * 2;
constexpr size_t OFF_WINT = OFF_W2T  + (size_t)8 * 1024 * 2816 * 2;
constexpr size_t OFF_WOT  = OFF_WINT + (size_t)4 * 2304 * 1024 * 2;
constexpr size_t OFF_GLUT = OFF_WOT  + (size_t)4 * 1024 * 1024 * 2;
constexpr size_t OFF_MOD  = OFF_GLUT + (size_t)4 * 512 * 256 * 2;
constexpr size_t OFF_ABAR = OFF_MOD  + (size_t)4 * 9 * 9216 * 4;
constexpr size_t OFF_BBAR = OFF_ABAR + (size_t)8192 * 2 * 4;
constexpr size_t OFF_LB   = OFF_BBAR + (size_t)8192 * 32 * 4;
constexpr size_t OFF_ROPE = OFF_LB   + (size_t)4 * 512 * 4;
constexpr size_t OFF_CNT  = OFF_ROPE + (size_t)2048 * 4;
constexpr size_t OFF_BAR  = OFF_CNT  + 256;
constexpr size_t OFF_PART = (OFF_BAR + 5504 * 4 + 255) / 256 * 256;
constexpr size_t OFF_ACT  = OFF_PART + (size_t)4 * NCTX * DM * 4;
constexpr size_t WS_END   = OFF_ACT  + (size_t)NROW * DFF * 2;

struct Grp { int gi, nx, rank, nloc; };
struct Params {
  const float *x, *c, *ctx, *c_ctx, *ada_w, *ada_b, *norm_g, *ffn_w1, *ffn_w2, *w_in, *w_out, *lbnd, *hnorm_g, *sink;
  const float *a_re, *a_im, *log_dt, *b_re, *b_im, *c_re, *c_im, *s5_d, *glu_w, *glu_b, *final_g;
  float* out;
  unsigned char* ws;
};

DEVI unsigned short f2bf(float x) { const __bf16 b = (__bf16)x; return __builtin_bit_cast(unsigned short, b); }
DEVI float silu_f(float x) { return x * __builtin_amdgcn_rcpf(1.f + __expf(-x)); }
DEVI float shx(float v, int k, int lane) { return __int_as_float(__builtin_amdgcn_ds_bpermute((lane ^ k) << 2, __float_as_int(v))); }
DEVI float wave_sum(float v, int lane) { for (int o = 32; o > 0; o >>= 1) v += shx(v, o, lane); return v; }

DEVI void transpose_tile(const float* __restrict__ src, bf16_t* __restrict__ dst, int K, int N, int k0, int n0, int drow0, float* T) {
  const int tid = threadIdx.x;
  { const int r = tid >> 4, c4 = tid & 15;
    for (int rr = r; rr < 64; rr += 32) {
      const float4 v = *(const float4*)(src + (size_t)(k0 + rr) * N + n0 + c4 * 4);
      T[rr * 65 + c4 * 4 + 0] = v.x; T[rr * 65 + c4 * 4 + 1] = v.y; T[rr * 65 + c4 * 4 + 2] = v.z; T[rr * 65 + c4 * 4 + 3] = v.w;
    } }
  __syncthreads();
  { const int n = tid >> 3, k8 = tid & 7;
    bf16x8 o;
#pragma unroll
    for (int i = 0; i < 8; ++i) o[i] = (short)f2bf(T[(k8 * 8 + i) * 65 + n]);
    *(bf16x8*)(dst + (size_t)(drow0 + n) * K + k0 + k8 * 8) = o; }
  __syncthreads();
}
DEVI int perm_row(int n0, int half) { const int hi = n0 >= half; const int j0 = n0 - hi * half; return (j0 >> 7) * 256 + hi * 128 + (j0 & 127); }

__device__ void phase0(const Params& p) {
  extern __shared__ __attribute__((aligned(16))) unsigned char lds_raw[];
  float* L = (float*)lds_raw;
  const int tid = threadIdx.x, nb = gridDim.x, bid = blockIdx.x;
  if (bid == 0) { if (tid < 64) ((int*)(p.ws + OFF_CNT))[tid] = 0; for (int i = tid; i < 5504; i += NTHR) ((unsigned*)(p.ws + OFF_BAR))[i] = 0u; }
  { const int gi = bid * NTHR + tid, gs = nb * NTHR;
    float* rc = (float*)(p.ws + OFF_ROPE); float* rs = rc + 1024;
    for (int e = gi; e < 1024; e += gs) { const int pos = e >> 4, i = e & 15; const float inv = powf(10000.f, -(float)i / 16.f); const float a = (float)pos * inv; rc[e] = cosf(a); rs[e] = sinf(a); }
    float* lb = (float*)(p.ws + OFF_LB);
    for (int e = gi; e < 512; e += gs) {
      const float v0 = p.lbnd[e], v1 = p.lbnd[512 + e], v2 = p.lbnd[1024 + e], v3 = p.lbnd[1536 + e];
      const float mx = fmaxf(fmaxf(v0, v1), fmaxf(v2, v3));
      const float e0 = expf(v0 - mx), e1 = expf(v1 - mx), e2 = expf(v2 - mx), e3 = expf(v3 - mx);
      const float inv = 1.f / (e0 + e1 + e2 + e3);
      lb[e] = 0.f; lb[512 + e] = e1 * inv; lb[1024 + e] = (e1 + e2) * inv; lb[1536 + e] = (e1 + e2 + e3) * inv;
    }
    float* ab = (float*)(p.ws + OFF_ABAR); float* bb = (float*)(p.ws + OFF_BBAR);
    for (int e = gi; e < 8192; e += gs) {
      const int pp = e & 63, g = (e >> 6) & 15, l = e >> 11;
      const float are = p.a_re[e], aim = p.a_im[e];
      const float dt = expf(p.log_dt[e >> 6]);
      const float mag = expf(are * dt), ang = aim * dt;
      const float abr = mag * cosf(ang), abi = mag * sinf(ang);
      const float den = are * are + aim * aim;
      const float cr = ((abr - 1.f) * are + abi * aim) / den;
      const float ci = (abi * are - (abr - 1.f) * aim) / den;
      ab[e * 2] = abr; ab[e * 2 + 1] = abi;
      const float* br = p.b_re + ((size_t)(l * 16 + g) * 64 + pp) * 16; const float* bi = p.b_im + ((size_t)(l * 16 + g) * 64 + pp) * 16;
      for (int c = 0; c < 16; ++c) { const float r = br[c], i2 = bi[c]; bb[((size_t)((e >> 6) * 2 + 0) * 64 + pp) * 16 + c] = cr * r - ci * i2; bb[((size_t)((e >> 6) * 2 + 1) * 64 + pp) * 16 + c] = cr * i2 + ci * r; }
    }
  }
  constexpr int N_MOD = 144;
  if (bid < N_MOD) {
    const int it = bid;
    float* SC = L; float* RED = L + 9216;
    for (int e = tid; e < 9216; e += NTHR) { const int r = e >> 10, k = e & 1023; const float v = (r < 8) ? p.c[r * 1024 + k] : p.c_ctx[k]; SC[e] = silu_f(v); }
    __syncthreads();
    const int cb = it * 256, l = cb / 9216, n0 = cb % 9216;
    const int cq = tid & 63, kg = tid >> 6;
    float acc[9][4];
#pragma unroll
    for (int r = 0; r < 9; ++r) { acc[r][0] = 0.f; acc[r][1] = 0.f; acc[r][2] = 0.f; acc[r][3] = 0.f; }
    const float* wp = p.ada_w + ((size_t)l * 1024 + kg * 128) * 9216 + n0 + cq * 4;
#pragma unroll 8
    for (int kk = 0; kk < 128; ++kk) {
      const float4 w = *(const float4*)(wp + (size_t)kk * 9216);
#pragma unroll
      for (int r = 0; r < 9; ++r) { const float s = SC[r * 1024 + kg * 128 + kk]; acc[r][0] += s * w.x; acc[r][1] += s * w.y; acc[r][2] += s * w.z; acc[r][3] += s * w.w; }
    }
#pragma unroll
    for (int r = 0; r < 9; ++r) *(float4*)(RED + (kg * 9 + r) * 256 + cq * 4) = make_float4(acc[r][0], acc[r][1], acc[r][2], acc[r][3]);
    __syncthreads();
    float* mod = (float*)(p.ws + OFF_MOD);
    for (int e = tid; e < 2304; e += NTHR) {
      const int r = e >> 8, cc = e & 255; float s = p.ada_b[l * 9216 + n0 + cc];
      for (int k2 = 0; k2 < 8; ++k2) s += RED[(k2 * 9 + r) * 256 + cc];
      mod[(size_t)(l * 9 + r) * 9216 + n0 + cc] = s;
    }
    __syncthreads();
  }
  {
    constexpr int T_W1 = 8 * 16 * 22, T_W2 = 8 * 44 * 4, T_WIN = 4 * 16 * 9, T_WO = 4 * 16 * 4, T_GLU = 4 * 4 * 2;
    constexpr int N_TR = T_W1 + T_W2 + T_WIN + T_WO + T_GLU;
    float* T = L;
    for (int t0 = bid; t0 < N_TR; t0 += nb) {
      int t = t0; const float* srcp; bf16_t* dstp; int K, N, k0, n0, half;
      if (t < T_W1) { const int mat = t / 352, tl = t % 352; k0 = (tl / 22) * 64; n0 = (tl % 22) * 256; K = 1024; N = 5632; half = 2816;
        srcp = p.ffn_w1 + (size_t)mat * 1024 * 5632; dstp = (bf16_t*)(p.ws + OFF_W1T) + (size_t)mat * 5632 * 1024;
      } else if ((t -= T_W1) < T_W2) { const int mat = t / 176, tl = t % 176; k0 = (tl / 4) * 64; n0 = (tl % 4) * 256; K = 2816; N = 1024; half = 0;
        srcp = p.ffn_w2 + (size_t)mat * 2816 * 1024; dstp = (bf16_t*)(p.ws + OFF_W2T) + (size_t)mat * 1024 * 2816;
      } else if ((t -= T_W2) < T_WIN) { const int mat = t / 144, tl = t % 144; k0 = (tl / 9) * 64; n0 = (tl % 9) * 256; K = 1024; N = 2304; half = 0;
        srcp = p.w_in + (size_t)mat * 1024 * 2304; dstp = (bf16_t*)(p.ws + OFF_WINT) + (size_t)mat * 2304 * 1024;
      } else if ((t -= T_WIN) < T_WO) { const int mat = t / 64, tl = t % 64; k0 = (tl / 4) * 64; n0 = (tl % 4) * 256; K = 1024; N = 1024; half = 0;
        srcp = p.w_out + (size_t)mat * 1024 * 1024; dstp = (bf16_t*)(p.ws + OFF_WOT) + (size_t)mat * 1024 * 1024;
      } else { t -= T_WO; const int mat = t / 8, tl = t % 8; k0 = (tl / 2) * 64; n0 = (tl % 2) * 256; K = 256; N = 512; half = 256;
        srcp = p.glu_w + (size_t)mat * 256 * 512; dstp = (bf16_t*)(p.ws + OFF_GLUT) + (size_t)mat * 512 * 256;
      }
      { const int r = tid >> 6, c4 = tid & 63;
        float4 v[8];
#pragma unroll
        for (int i = 0; i < 8; ++i) v[i] = *(const float4*)(srcp + (size_t)(k0 + r + 8 * i) * N + n0 + c4 * 4);
#pragma unroll
        for (int i = 0; i < 8; ++i) { float* tp = T + (r + 8 * i) * 257 + c4 * 4; tp[0] = v[i].x; tp[1] = v[i].y; tp[2] = v[i].z; tp[3] = v[i].w; } }
      __syncthreads();
      { const int nn = tid >> 1, kh = tid & 1;
        const int ng = n0 + (nn & 128);
        const int drow = (half ? perm_row(ng, half) : ng) + (nn & 127);
#pragma unroll
        for (int q = 0; q < 4; ++q) {
          const int k8 = kh * 4 + q; bf16x8 o;
#pragma unroll
          for (int i = 0; i < 8; ++i) o[i] = (short)f2bf(T[(k8 * 8 + i) * 257 + nn]);
          *(bf16x8*)(dstp + (size_t)drow * K + k0 + k8 * 8) = o;
        } }
      __syncthreads();
    }
  }
}

__device__ void phase_adaln(const Params& p, const Grp gr, int l, int i, int nrows, const float* pend_gate, const float pend_coef, const float* xlat, const float* xctx) {
  int tid0 = threadIdx.x; asm volatile("" : "+v"(tid0));
  const int lane = tid0 & 63, gw = blockIdx.x * 8 + (tid0 >> 6), nw = gridDim.x * 8;
  float* X = (float*)(p.ws + OFF_X); bf16_t* H = (bf16_t*)(p.ws + OFF_H);
  const float* PART = (const float*)(p.ws + OFF_PART);
  const float* g = p.norm_g + (size_t)(l * 3 + i) * 1024;
  const int lw = gr.rank * 8 + (tid0 >> 6), nlw = gr.nloc * 8;
  const int per_b = (nrows > NLAT) ? 2304 : 2048;
  for (int xb = gr.gi; xb < 8; xb += gr.nx)
  for (int it = lw; it < per_b; it += nlw) {
    const int row = (it < 2048) ? xb * 2048 + it : NLAT + xb * 256 + (it - 2048);
    const int mr = (row < NLAT) ? (row >> 11) : 8;
    const float* mod = (const float*)(p.ws + OFF_MOD) + (size_t)(l * 9 + mr) * 9216 + i * 3072;
    float4 v[4]; float ss = 0.f;
    const float* xr = (row < NLAT) ? (xlat ? xlat + (size_t)row * 1024 : X + (size_t)row * 1024) : (xctx ? xctx + (size_t)(row - NLAT) * 1024 : X + (size_t)row * 1024);
#pragma unroll
    for (int q = 0; q < 4; ++q) v[q] = *(const float4*)(xr + q * 256 + lane * 4);
    if (pend_gate != nullptr && row >= NLAT) {
#pragma unroll
      for (int q = 0; q < 4; ++q) {
        const int col = q * 256 + lane * 4; const size_t o = (size_t)(row - NLAT) * 1024 + col;
        const float4 a = *(const float4*)(PART + o), b = *(const float4*)(PART + (size_t)NCTX * 1024 + o), c = *(const float4*)(PART + (size_t)2 * NCTX * 1024 + o), d = *(const float4*)(PART + (size_t)3 * NCTX * 1024 + o);
        const float4 gt = *(const float4*)(pend_gate + col);
        v[q].x += pend_coef * gt.x * ((a.x + b.x) + (c.x + d.x)); v[q].y += pend_coef * gt.y * ((a.y + b.y) + (c.y + d.y));
        v[q].z += pend_coef * gt.z * ((a.z + b.z) + (c.z + d.z)); v[q].w += pend_coef * gt.w * ((a.w + b.w) + (c.w + d.w));
        *(float4*)(X + (size_t)row * 1024 + col) = v[q];
      }
    }
#pragma unroll
    for (int q = 0; q < 4; ++q) ss += v[q].x * v[q].x + v[q].y * v[q].y + v[q].z * v[q].z + v[q].w * v[q].w;
    ss = wave_sum(ss, lane);
    const float rstd = rsqrtf(ss * (1.f / 1024.f) + 1e-6f);
#pragma unroll
    for (int q = 0; q < 4; ++q) {
      const int col = q * 256 + lane * 4;
      const float4 gg = *(const float4*)(g + col), sh = *(const float4*)(mod + col), sc = *(const float4*)(mod + 1024 + col);
      s16x4 o;
      o[0] = (short)f2bf(v[q].x * rstd * gg.x * (1.f + sc.x) + sh.x); o[1] = (short)f2bf(v[q].y * rstd * gg.y * (1.f + sc.y) + sh.y);
      o[2] = (short)f2bf(v[q].z * rstd * gg.z * (1.f + sc.z) + sh.z); o[3] = (short)f2bf(v[q].w * rstd * gg.w * (1.f + sc.w) + sh.w);
      *(s16x4*)(H + (size_t)row * 1024 + col) = o;
    }
  }
}
__device__ void phase_final(const Params& p, const Grp gr) {
  int tid0 = threadIdx.x; asm volatile("" : "+v"(tid0));
  const int lane = tid0 & 63, gw = blockIdx.x * 8 + (tid0 >> 6), nw = gridDim.x * 8;
  const float* X = (const float*)(p.ws + OFF_X);
  const int lw = gr.rank * 8 + (tid0 >> 6), nlw = gr.nloc * 8;
  for (int xb = gr.gi; xb < 8; xb += gr.nx)
  for (int it = lw; it < 2048; it += nlw) {
    const int row = xb * 2048 + it;
    float4 v[4]; float ss = 0.f;
#pragma unroll
    for (int q = 0; q < 4; ++q) { v[q] = *(const float4*)(X + (size_t)row * 1024 + q * 256 + lane * 4); ss += v[q].x * v[q].x + v[q].y * v[q].y + v[q].z * v[q].z + v[q].w * v[q].w; }
    ss = wave_sum(ss, lane);
    const float rstd = rsqrtf(ss * (1.f / 1024.f) + 1e-6f);
#pragma unroll
    for (int q = 0; q < 4; ++q) {
      const int col = q * 256 + lane * 4; const float4 gg = *(const float4*)(p.final_g + col);
      *(float4*)(p.out + (size_t)row * 1024 + col) = make_float4(v[q].x * rstd * gg.x, v[q].y * rstd * gg.y, v[q].z * rstd * gg.z, v[q].w * rstd * gg.w);
    }
  }
}

constexpr int BM = 256, BK = 64, HALF = 128, HT = HALF * BK;
DEVI int lds_byte(int r, int c) { const int st = (r >> 4) * 2 + (c >> 5), rr = r & 15, cc = c & 31, ob = rr * 64 + cc * 2; return st * 1024 + (ob ^ (((ob >> 9) & 1) << 5)); }
DEVI void stage_rc(int b, int& R, int& C) { const int st = b / 1024, sb = b % 1024, swz = sb ^ (((sb >> 9) & 1) << 5); R = (st >> 1) * 16 + swz / 64; C = (st & 1) * 32 + (swz % 64) / 2; }

struct EpiArgs { float* outf; bf16_t* outb; const float* aux; float coef; int ldo; int coloff; float* part; const float* xin; };

__device__ __forceinline__ void gemm_phase(const Grp gr, const int EPI, const bf16_t* __restrict__ A, const bf16_t* __restrict__ Bt, int nM, int nN, int K, const EpiArgs ea) {
  extern __shared__ __attribute__((aligned(16))) unsigned char lds_raw[];
  bf16_t* shm = (bf16_t*)lds_raw;
#define SA(b, h) (shm + ((b) * 2 + (h)) * HT)
#define SB(b, h) (shm + (4 + (b) * 2 + (h)) * HT)
#define STAGE(P_, BASE, br, kt) do { const char* _sb = (const char*)(BASE) + ((long)(br) * K + (long)kofs + (long)(kt) * BK) * 2; \
    unsigned _v0 = voff0, _v1 = voff1; asm volatile("" : "+v"(_v0), "+v"(_v1)); \
    __builtin_amdgcn_global_load_lds((const unsigned*)(_sb + (size_t)_v0), (unsigned*)((char*)(P_) + lb0), 16, 0, 0); \
    __builtin_amdgcn_global_load_lds((const unsigned*)(_sb + (size_t)_v1), (unsigned*)((char*)(P_) + lb0 + 8192), 16, 0, 0); } while (0)
#define LDA(dst, b, h) for (int m = 0; m < 4; ++m) for (int k = 0; k < 2; ++k) \
    dst[m][k] = *reinterpret_cast<const bf16x8*>((char*)SA(b, h) + aoff + m * 2048 + k * 1024)
#define LDB(dst, b, h) for (int n = 0; n < 2; ++n) for (int k = 0; k < 2; ++k) \
    dst[n][k] = *reinterpret_cast<const bf16x8*>((char*)SB(b, h) + boff + n * 2048 + k * 1024)
#define MMA(ai, bj, At_, Bt_) do { __builtin_amdgcn_s_setprio(1); \
    for (int m = 0; m < 4; ++m) for (int n = 0; n < 2; ++n) for (int k = 0; k < 2; ++k) \
      acc[ai][bj][m][n] = __builtin_amdgcn_mfma_f32_16x16x32_bf16(Bt_[n][k], At_[m][k], acc[ai][bj][m][n], 0, 0, 0); \
    __builtin_amdgcn_s_setprio(0); } while (0)
#define WAIT_V(n) asm volatile("s_waitcnt vmcnt(" #n ")" ::: "memory")
#define WAIT_L(n) asm volatile("s_waitcnt lgkmcnt(" #n ")" ::: "memory")
#define BAR __builtin_amdgcn_s_barrier()
#define SCHED __builtin_amdgcn_sched_barrier(0)
  const int G = gridDim.x;
  int tidx = threadIdx.x; asm volatile("" : "+v"(tidx));
  const int wid = __builtin_amdgcn_readfirstlane(tidx >> 6), lane = tidx & 63, wr = wid >> 2, wc = wid & 3, fr = lane & 15, fq = lane >> 4;
  const int nt = K / BK;
  const int lb0 = tidx * 16;
  unsigned voff0, voff1;
  { int r0, c0; stage_rc(lb0, r0, c0); voff0 = (unsigned)(r0 * K + c0) * 2u; stage_rc(lb0 + 8192, r0, c0); voff1 = (unsigned)(r0 * K + c0) * 2u; }
  const int swz_l = lds_byte(fr, fq * 8);
  const int aoff = wr * 8192 + swz_l, boff = wc * 4096 + swz_l;
  const int pR = (nM > 64) ? 9 : 8;
  const bool tailk = (EPI == 2) && (pR == 9);
  const int nfullb = (tailk ? 8 : pR) * nN, Ub = nfullb + (tailk ? 4 * nN : 0);
  const int nbg = (8 - gr.gi + gr.nx - 1) / gr.nx;
  for (int unit = gr.rank; unit < nbg * Ub; unit += gr.nloc) {
    const int bsel = gr.gi + (unit / Ub) * gr.nx, u = unit % Ub;
    int pm, pn, kofs = 0, ntu = nt, split = -1;
    if (u < nfullb) {
      const int rdiv = tailk ? 8 : pR; const int rt = u % rdiv; pn = u / rdiv; pm = (rt < 8) ? 8 * bsel + rt : 64 + bsel;
    } else {
      const int q = u - nfullb; split = q & 3; pn = q >> 2; pm = 64 + bsel;
      int kt0;
      if (nt == 44) { kt0 = (split == 0) ? 0 : (split == 1) ? 12 : (split == 2) ? 24 : 34; ntu = (split < 2) ? 12 : 10; }
      else { ntu = nt >> 2; kt0 = split * ntu; }
      kofs = kt0 * BK;
    }
    const int brow = pm * BM, bcol = pn * BM;
    f32x4 acc[2][2][4][2];
#pragma unroll
    for (int a = 0; a < 2; ++a)
#pragma unroll
      for (int b = 0; b < 2; ++b)
#pragma unroll
        for (int m = 0; m < 4; ++m)
#pragma unroll
          for (int n = 0; n < 2; ++n) acc[a][b][m][n] = f32x4{0.f, 0.f, 0.f, 0.f};
    bf16x8 At[4][2], B0[2][2], B1[2][2];
    STAGE(SB(0, 0), Bt, bcol, 0); STAGE(SA(0, 0), A, brow, 0);
    STAGE(SB(0, 1), Bt, bcol + HALF, 0); STAGE(SA(0, 1), A, brow + HALF, 0);
    if (wr == 1) BAR;
    WAIT_V(4); BAR;
    STAGE(SB(1, 0), Bt, bcol, 1); STAGE(SA(1, 0), A, brow, 1); STAGE(SB(1, 1), Bt, bcol + HALF, 1);
    WAIT_V(6); BAR;
    for (int t = 0; t < ntu - 2; t += 2) {
      LDB(B0, 0, 0); SCHED; LDA(At, 0, 0); STAGE(SA(1, 1), A, brow + HALF, t + 1);
      WAIT_L(8); BAR; WAIT_L(0); MMA(0, 0, At, B0); BAR; SCHED;
      LDB(B1, 0, 1); STAGE(SB(0, 0), Bt, bcol, t + 2);
      BAR; WAIT_L(0); MMA(0, 1, At, B1); BAR;
      LDA(At, 0, 1); STAGE(SA(0, 0), A, brow, t + 2);
      BAR; WAIT_L(0); MMA(1, 0, At, B0); BAR; SCHED;
      STAGE(SB(0, 1), Bt, bcol + HALF, t + 2);
      WAIT_V(6); BAR; MMA(1, 1, At, B1); BAR;
      LDB(B0, 1, 0); SCHED; LDA(At, 1, 0); STAGE(SA(0, 1), A, brow + HALF, t + 2);
      WAIT_L(8); BAR; WAIT_L(0); MMA(0, 0, At, B0); BAR; SCHED;
      LDB(B1, 1, 1); STAGE(SB(1, 0), Bt, bcol, t + 3);
      BAR; WAIT_L(0); MMA(0, 1, At, B1); BAR;
      LDA(At, 1, 1); STAGE(SA(1, 0), A, brow, t + 3);
      BAR; WAIT_L(0); MMA(1, 0, At, B0); BAR; SCHED;
      STAGE(SB(1, 1), Bt, bcol + HALF, t + 3);
      WAIT_V(6); BAR; MMA(1, 1, At, B1); BAR;
    }
    { LDB(B0, 0, 0); LDA(At, 0, 0); STAGE(SA(1, 1), A, brow + HALF, ntu - 1);
      BAR; WAIT_L(0); MMA(0, 0, At, B0); BAR;
      LDB(B1, 0, 1); BAR; WAIT_L(0); MMA(0, 1, At, B1); BAR;
      LDA(At, 0, 1); WAIT_V(4); BAR; WAIT_L(0); MMA(1, 0, At, B0); MMA(1, 1, At, B1); BAR; }
    { LDB(B0, 1, 0); LDA(At, 1, 0); WAIT_V(2); BAR; WAIT_L(0); MMA(0, 0, At, B0); BAR;
      LDB(B1, 1, 1); WAIT_V(0); BAR; WAIT_L(0); MMA(0, 1, At, B1); BAR;
      LDA(At, 1, 1); BAR; WAIT_L(0); MMA(1, 0, At, B0); MMA(1, 1, At, B1); BAR; }
    if (wr == 0) BAR;
    const int mr = (brow < NLAT) ? (brow >> 11) : 8;
    int t2 = threadIdx.x; asm volatile("" : "+v"(t2));
    const int fr_e = t2 & 15, fq_e = (t2 >> 4) & 3;
#define EPI_LOOP(BODY) _Pragma("unroll") for (int ai = 0; ai < 2; ++ai) _Pragma("unroll") for (int m = 0; m < 4; ++m) { \
      const size_t row = (size_t)(brow + ai * HALF + wr * 64 + m * 16 + fr_e); BODY }
    if (EPI == 0) {
      EPI_LOOP(
        _Pragma("unroll") for (int bj = 0; bj < 2; ++bj) _Pragma("unroll") for (int n = 0; n < 2; ++n) { const f32x4 v = acc[ai][bj][m][n];
          *(float4*)(ea.outf + row * ea.ldo + bcol + bj * HALF + wc * 32 + n * 16 + fq_e * 4) = make_float4(v[0], v[1], v[2], v[3]); } )
    } else if (EPI == 1) {
      EPI_LOOP(
        _Pragma("unroll") for (int n = 0; n < 2; ++n) { const f32x4 gt = acc[ai][0][m][n]; const f32x4 up = acc[ai][1][m][n]; s16x4 o;
          _Pragma("unroll") for (int j = 0; j < 4; ++j) o[j] = (short)f2bf(gt[j] * __builtin_amdgcn_rcpf(1.f + __expf(-gt[j])) * up[j]);
          *(s16x4*)(ea.outb + row * ea.ldo + pn * HALF + wc * 32 + n * 16 + fq_e * 4) = o; } )
    } else if (EPI == 2 && split >= 0) {
      EPI_LOOP(
        _Pragma("unroll") for (int bj = 0; bj < 2; ++bj) _Pragma("unroll") for (int n = 0; n < 2; ++n) { const f32x4 v = acc[ai][bj][m][n];
          *(float4*)(ea.part + ((size_t)split * NCTX + (row - NLAT)) * 1024 + bcol + bj * HALF + wc * 32 + n * 16 + fq_e * 4) = make_float4(v[0], v[1], v[2], v[3]); } )
    } else if (EPI == 2) {
      EPI_LOOP(
        _Pragma("unroll") for (int bj = 0; bj < 2; ++bj) _Pragma("unroll") for (int n = 0; n < 2; ++n) { const int col = bcol + bj * HALF + wc * 32 + n * 16 + fq_e * 4;
          const f32x4 v = acc[ai][bj][m][n]; const float4 g = *(const float4*)(ea.aux + mr * 9216 + col);
          float4* xp = (float4*)(ea.outf + row * 1024 + col); float4 x = *(const float4*)(ea.xin + row * 1024 + col);
          x.x += ea.coef * g.x * v[0]; x.y += ea.coef * g.y * v[1]; x.z += ea.coef * g.z * v[2]; x.w += ea.coef * g.w * v[3]; *xp = x; } )
    } else {
      EPI_LOOP(
        _Pragma("unroll") for (int n = 0; n < 2; ++n) { const int cl = pn * HALF + wc * 32 + n * 16 + fq_e * 4;
          const f32x4 av = acc[ai][0][m][n]; const f32x4 bv = acc[ai][1][m][n];
          const float4 ba = *(const float4*)(ea.aux + cl); const float4 bb = *(const float4*)(ea.aux + 256 + cl); s16x4 o;
          o[0] = (short)f2bf((av[0] + ba.x) * __builtin_amdgcn_rcpf(1.f + __expf(-(bv[0] + bb.x)))); o[1] = (short)f2bf((av[1] + ba.y) * __builtin_amdgcn_rcpf(1.f + __expf(-(bv[1] + bb.y))));
          o[2] = (short)f2bf((av[2] + ba.z) * __builtin_amdgcn_rcpf(1.f + __expf(-(bv[2] + bb.z)))); o[3] = (short)f2bf((av[3] + ba.w) * __builtin_amdgcn_rcpf(1.f + __expf(-(bv[3] + bb.w))));
          *(s16x4*)(ea.outb + row * ea.ldo + ea.coloff + cl) = o; } )
    }
#undef EPI_LOOP
    __syncthreads();
  }
#undef SA
#undef SB
}

DEVI int seq_row(int b, int dir, int i) {
  if (i < 256) { const int s = dir ? 255 - i : i; return NLAT + b * 256 + s; }
  const int j = i - 256; const int t = dir ? 2047 - j : j; return b * 2048 + t;
}

DEVI int mirror_blk(int nf) { return nf < 4 ? 3 - nf : 39 - nf; }

DEVI bf16x8 pk8(float a0, float a1, float a2, float a3, float b0, float b1, float b2, float b3) {
  bf16x8 r; r[0] = (short)f2bf(a0); r[1] = (short)f2bf(a1); r[2] = (short)f2bf(a2); r[3] = (short)f2bf(a3);
  r[4] = (short)f2bf(b0); r[5] = (short)f2bf(b1); r[6] = (short)f2bf(b2); r[7] = (short)f2bf(b3); return r;
}
template <int C> DEVI float dppz(float v) { return __int_as_float(__builtin_amdgcn_update_dpp(0, __float_as_int(v), C, 0xf, 0xf, true)); }
DEVI float bperm(float v, int srclane) { return __int_as_float(__builtin_amdgcn_ds_bpermute(srclane << 2, __float_as_int(v))); }
#define MFMA16(a, b, c) __builtin_amdgcn_mfma_f32_16x16x32_bf16((a), (b), (c), 0, 0, 0)

template <int MODE>
DEVI void hgrn_wave_block(const Params& p, const float* __restrict__ P, float* KS, const int l, const int b, const int h, const int dir, const int n, const int lane,
                          f32x4 (&S)[4][4], float (&dsum)[4][4]) {
  const int fr = lane & 15, fq = lane >> 4;
  const int zb = (dir ? 768 : 512) + h * 64 + 4 * fq;
  float* OF = (float*)(p.ws + OFF_YS + (8u << 20));
  float lbv[4][4];
#pragma unroll
  for (int m = 0; m < 4; ++m) { const float4 t = *(const float4*)((const float*)(p.ws + OFF_LB) + (l * 2 + dir) * 256 + h * 64 + 16 * m + 4 * fq); lbv[m][0] = t.x; lbv[m][1] = t.y; lbv[m][2] = t.z; lbv[m][3] = t.w; }
#pragma unroll 1
  for (int c4 = 0; c4 < 4; ++c4) {
    const int i0 = 64 * n + 16 * c4;
    const size_t rt = (size_t)seq_row(b, dir, i0 + fr);
    float z[4][4], q[4][4], vv[4][4];
#pragma unroll
    for (int m = 0; m < 4; ++m) {
      const float4 t = *(const float4*)(P + rt * DIN + zb + 16 * m); z[m][0] = t.x; z[m][1] = t.y; z[m][2] = t.z; z[m][3] = t.w;
      if (MODE != 0) { const float4 u = *(const float4*)(P + rt * DIN + h * 64 + 16 * m + 4 * fq); q[m][0] = u.x; q[m][1] = u.y; q[m][2] = u.z; q[m][3] = u.w; }
    }
#pragma unroll
    for (int j = 0; j < 4; ++j) {
      const size_t rs = (size_t)seq_row(b, dir, i0 + 4 * fq + j);
#pragma unroll
      for (int nt = 0; nt < 4; ++nt) vv[nt][j] = P[rs * DIN + 256 + h * 64 + 16 * nt + fr];
    }
    float Qh[4][4], Kh[4][4], dec[4][4];
#pragma unroll
    for (int m = 0; m < 4; ++m) {
      float ku[4];
#pragma unroll
      for (int j = 0; j < 4; ++j) {
        const float zc = fminf(fmaxf(z[m][j], -80.f), 80.f);
        const float e1 = __expf(-zc), sig = __builtin_amdgcn_rcpf(1.f + e1);
        const float lb = lbv[m][j];
        const float lf = __logf(lb + (1.f - lb) * sig);
        const float kk = (1.f - lb) * e1 * sig;
        float B = lf;
        B += dppz<0x111>(B); B += dppz<0x112>(B); B += dppz<0x114>(B); B += dppz<0x118>(B);
        const float bs = bperm(B, lane | 15);
        const float Bc = fmaxf(B, -80.f);
        const float eB = __expf(Bc);
        Kh[m][j] = kk * __builtin_amdgcn_rcpf(eB);
        if (MODE != 0) Qh[m][j] = q[m][j] * __builtin_amdgcn_rcpf(1.f + __expf(-q[m][j])) * eB;
        dec[m][j] = __expf(bs);
        ku[j] = Kh[m][j] * dec[m][j];
        if (MODE == 0) dsum[m][j] += bs;
      }
      *(float4*)(KS + fr * 68 + 16 * m + 4 * fq) = make_float4(ku[0], ku[1], ku[2], ku[3]);
    }
    __builtin_amdgcn_fence(__ATOMIC_ACQ_REL, "wavefront"); __builtin_amdgcn_wave_barrier();
    bf16x8 KuTf[4], Vf[4];
#pragma unroll
    for (int mt = 0; mt < 4; ++mt) {
      const float a0 = KS[(4 * fq + 0) * 68 + 16 * mt + fr], a1 = KS[(4 * fq + 1) * 68 + 16 * mt + fr], a2 = KS[(4 * fq + 2) * 68 + 16 * mt + fr], a3 = KS[(4 * fq + 3) * 68 + 16 * mt + fr];
      KuTf[mt] = pk8(a0, a1, a2, a3, 0.f, 0.f, 0.f, 0.f);
      Vf[mt] = pk8(vv[mt][0], vv[mt][1], vv[mt][2], vv[mt][3], 0.f, 0.f, 0.f, 0.f);
    }
    __builtin_amdgcn_fence(__ATOMIC_ACQ_REL, "wavefront"); __builtin_amdgcn_wave_barrier();
    if (MODE != 0) {
      bf16x8 Qf[2], Kf[2];
#pragma unroll
      for (int ks = 0; ks < 2; ++ks) {
        Qf[ks] = pk8(Qh[2 * ks][0], Qh[2 * ks][1], Qh[2 * ks][2], Qh[2 * ks][3], Qh[2 * ks + 1][0], Qh[2 * ks + 1][1], Qh[2 * ks + 1][2], Qh[2 * ks + 1][3]);
        Kf[ks] = pk8(Kh[2 * ks][0], Kh[2 * ks][1], Kh[2 * ks][2], Kh[2 * ks][3], Kh[2 * ks + 1][0], Kh[2 * ks + 1][1], Kh[2 * ks + 1][2], Kh[2 * ks + 1][3]);
      }
      f32x4 sc = f32x4{0.f, 0.f, 0.f, 0.f};
      sc = MFMA16(Kf[0], Qf[0], sc); sc = MFMA16(Kf[1], Qf[1], sc);
      const bf16x8 Pf = pk8((4 * fq + 0 <= fr) ? sc[0] : 0.f, (4 * fq + 1 <= fr) ? sc[1] : 0.f, (4 * fq + 2 <= fr) ? sc[2] : 0.f, (4 * fq + 3 <= fr) ? sc[3] : 0.f, 0.f, 0.f, 0.f, 0.f);
      f32x4 O[4];
#pragma unroll
      for (int mt = 0; mt < 4; ++mt) {
        f32x4 o = f32x4{0.f, 0.f, 0.f, 0.f};
#pragma unroll
        for (int ks = 0; ks < 2; ++ks) {
          const bf16x8 Sf = pk8(S[2 * ks][mt][0], S[2 * ks][mt][1], S[2 * ks][mt][2], S[2 * ks][mt][3], S[2 * ks + 1][mt][0], S[2 * ks + 1][mt][1], S[2 * ks + 1][mt][2], S[2 * ks + 1][mt][3]);
          o = MFMA16(Sf, Qf[ks], o);
        }
        O[mt] = MFMA16(Vf[mt], Pf, o);
      }
      if (MODE == 1) {
#pragma unroll
        for (int mt = 0; mt < 4; ++mt) *(float4*)(OF + rt * 256 + h * 64 + 16 * mt + 4 * fq) = make_float4(O[mt][0], O[mt][1], O[mt][2], O[mt][3]);
      } else {
        float ss = 0.f;
#pragma unroll
        for (int mt = 0; mt < 4; ++mt) { const float4 of = *(const float4*)(OF + rt * 256 + h * 64 + 16 * mt + 4 * fq);
          O[mt][0] += of.x; O[mt][1] += of.y; O[mt][2] += of.z; O[mt][3] += of.w;
          ss += O[mt][0] * O[mt][0] + O[mt][1] * O[mt][1] + O[mt][2] * O[mt][2] + O[mt][3] * O[mt][3]; }
        ss += bperm(ss, lane ^ 16); ss += bperm(ss, lane ^ 32);
        const float rstd = rsqrtf(ss * (1.f / 64.f) + 1e-6f);
        bf16_t* MIX = (bf16_t*)(p.ws + OFF_MIX);
#pragma unroll
        for (int mt = 0; mt < 4; ++mt) {
          const float4 gg = *(const float4*)(P + rt * DIN + 1024 + h * 64 + 16 * mt + 4 * fq);
          const float4 hg = *(const float4*)(p.hnorm_g + l * 256 + h * 64 + 16 * mt + 4 * fq);
          s16x4 o;
          o[0] = (short)f2bf(O[mt][0] * rstd * hg.x * silu_f(gg.x)); o[1] = (short)f2bf(O[mt][1] * rstd * hg.y * silu_f(gg.y));
          o[2] = (short)f2bf(O[mt][2] * rstd * hg.z * silu_f(gg.z)); o[3] = (short)f2bf(O[mt][3] * rstd * hg.w * silu_f(gg.w));
          *(s16x4*)(MIX + rt * 1024 + h * 64 + 16 * mt + 4 * fq) = o;
        }
      }
    }
#pragma unroll
    for (int mtk = 0; mtk < 4; ++mtk)
#pragma unroll
      for (int ntv = 0; ntv < 4; ++ntv) {
        f32x4 s = S[mtk][ntv];
        s[0] *= dec[mtk][0]; s[1] *= dec[mtk][1]; s[2] *= dec[mtk][2]; s[3] *= dec[mtk][3];
        S[mtk][ntv] = MFMA16(KuTf[mtk], Vf[ntv], s);
      }
  }
}

DEVI void hgrn_load_S(const float* __restrict__ HU, const int lane_off, f32x4 (&S)[4][4]) {
#pragma unroll
  for (int mtk = 0; mtk < 4; ++mtk) {
    int off = lane_off + mtk * 1024; asm volatile("" : "+v"(off));
    const float* pm = HU + off;
#pragma unroll
    for (int ntv = 0; ntv < 4; ++ntv)
#pragma unroll
      for (int j = 0; j < 4; ++j) S[mtk][ntv][j] = pm[j * 64 + 16 * ntv];
  }
}
DEVI void hgrn_store_S(float* __restrict__ HU, const int lane_off, const f32x4 (&S)[4][4]) {
#pragma unroll
  for (int mtk = 0; mtk < 4; ++mtk) {
    int off = lane_off + mtk * 1024; asm volatile("" : "+v"(off));
    float* pm = HU + off;
#pragma unroll
    for (int ntv = 0; ntv < 4; ++ntv)
#pragma unroll
      for (int j = 0; j < 4; ++j) pm[j * 64 + 16 * ntv] = S[mtk][ntv][j];
  }
}
DEVI void hgrn_local_task(const Params& p, int l, int task, int lane, float* KS) {
  const int seq = task / 36, n = task % 36, b = seq >> 3, h = (seq >> 1) & 3, dir = seq & 1, fr = lane & 15, fq = lane >> 4;
  f32x4 S[4][4]; float dsum[4][4];
#pragma unroll
  for (int a = 0; a < 4; ++a)
#pragma unroll
    for (int c = 0; c < 4; ++c) { S[a][c] = f32x4{0.f, 0.f, 0.f, 0.f}; dsum[a][c] = 0.f; }
  hgrn_wave_block<0>(p, (const float*)(p.ws + OFF_P), KS, l, b, h, dir, n, lane, S, dsum);
  hgrn_store_S((float*)(p.ws + OFF_OA) + (size_t)(seq * 36 + n) * 4096, 4 * fq * 64 + fr, S);
  if (fr == 0) {
    float* HD = (float*)(p.ws + OFF_YS) + (seq * 36 + n) * 64;
#pragma unroll
    for (int m = 0; m < 4; ++m)
#pragma unroll
      for (int j = 0; j < 4; ++j) HD[16 * m + 4 * fq + j] = __expf(dsum[m][j]);
  }
}
DEVI void hgrn_out_task(const Params& p, int l, int task, int lane, float* KS) {
  const int b = task / 144, h = (task / 36) & 3, nf = task % 36, fr = lane & 15, fq = lane >> 4;
  if (l == 3 && nf < 4) return;
  const float* P = (const float*)(p.ws + OFF_P);
  f32x4 S[4][4]; float dsum[4][4];
  hgrn_load_S((const float*)(p.ws + OFF_OA) + (size_t)(((b * 4 + h) * 2 + 0) * 36 + nf) * 4096, 4 * fq * 64 + fr, S);
  hgrn_wave_block<1>(p, P, KS, l, b, h, 0, nf, lane, S, dsum);
  asm volatile("s_waitcnt vmcnt(0)" ::: "memory");
  __builtin_amdgcn_fence(__ATOMIC_ACQUIRE, "agent");
  hgrn_load_S((const float*)(p.ws + OFF_OA) + (size_t)(((b * 4 + h) * 2 + 1) * 36 + mirror_blk(nf)) * 4096, 4 * fq * 64 + fr, S);
  hgrn_wave_block<2>(p, P, KS, l, b, h, 1, mirror_blk(nf), lane, S, dsum);
}

__device__ void hgrn_scan_item(const Params& p, int j) {
  int tid = threadIdx.x; asm volatile("" : "+v"(tid));
  const int seq = j >> 3, el = (j & 7) * 512 + tid, k = el >> 6;
  float* HU = (float*)(p.ws + OFF_OA) + (size_t)seq * 36 * 4096 + el;
  const float* HD = (const float*)(p.ws + OFF_YS) + seq * 36 * 64 + k;
  float s = 0.f;
#pragma unroll 6
  for (int n = 0; n < 36; ++n) { const float u = HU[(size_t)n * 4096]; const float d = HD[n * 64]; HU[(size_t)n * 4096] = s; s = d * s + u; }
}
DEVI int crow(int i, int h) { return (i & 3) + 8 * (i >> 2) + 4 * h; }
DEVI void split8(const float4 a, const float4 b, const float sgn, bf16x8& hi, bf16x8& lo) {
  const float v[8] = {a.x, a.y, a.z, a.w, b.x, b.y, b.z, b.w};
#pragma unroll
  for (int j = 0; j < 8; ++j) { const float x = sgn * v[j]; const unsigned short hh = f2bf(x); hi[j] = (short)hh; lo[j] = (short)f2bf(x - __uint_as_float((unsigned)hh << 16)); }
}
DEVI int sphys(int t, int col) { return t * 128 + ((((col >> 2) ^ (t & 7)) << 2) | (col & 3)); }

template <int MODE>
DEVI void s5_wave_dir(const Params& p, const float* __restrict__ P, float* SB, const int l, const int b, const int g, const int dir, const int n, const int lane, float& hr, float& hi, f32x4 (&Y)[4]) {
  const int e = (l * 2 + dir) * 16 + g;
  const int r = lane & 31, h = lane >> 5, fr = lane & 15, fq = lane >> 4;
  const float ar = ((const float*)(p.ws + OFF_ABAR))[(e * 64 + lane) * 2], ai = ((const float*)(p.ws + OFF_ABAR))[(e * 64 + lane) * 2 + 1];
  bf16x8 bh[4], bl[4];
#pragma unroll
  for (int nt = 0; nt < 4; ++nt) {
    const int n_ = 32 * nt + r, ri = n_ >> 6, pq = n_ & 63;
    const float* bp = (const float*)(p.ws + OFF_BBAR) + ((size_t)((e * 2 + ri) * 64 + pq)) * 16 + 8 * h;
    split8(*(const float4*)bp, *(const float4*)(bp + 4), 1.f, bh[nt], bl[nt]);
  }
  bf16x8 chh[4], chl[4];
  if (MODE == 1) {
#pragma unroll
    for (int ks = 0; ks < 4; ++ks) {
      const float* cp = ((ks < 2) ? p.c_re : p.c_im) + (size_t)e * 1024 + fr * 64 + (ks & 1) * 32 + fq * 8;
      split8(*(const float4*)cp, *(const float4*)(cp + 4), (ks < 2) ? 1.f : -1.f, chh[ks], chl[ks]);
    }
  }
  float4 ur[2][2];
#pragma unroll
  for (int hb = 0; hb < 2; ++hb) { const float* up = P + (size_t)seq_row(b, dir, 64 * n + 32 * hb + r) * DIN + 2048 + g * 16 + 8 * h; ur[hb][0] = *(const float4*)up; ur[hb][1] = *(const float4*)(up + 4); }
#pragma unroll
  for (int hb = 0; hb < 2; ++hb) {
    { bf16x8 uh, ul; split8(ur[hb][0], ur[hb][1], 1.f, uh, ul);
#pragma unroll
      for (int nt = 0; nt < 4; ++nt) {
        f32x16 x;
#pragma unroll
        for (int i = 0; i < 16; ++i) x[i] = 0.f;
        x = __builtin_amdgcn_mfma_f32_32x32x16_bf16(uh, bh[nt], x, 0, 0, 0);
        x = __builtin_amdgcn_mfma_f32_32x32x16_bf16(uh, bl[nt], x, 0, 0, 0);
        x = __builtin_amdgcn_mfma_f32_32x32x16_bf16(ul, bh[nt], x, 0, 0, 0);
#pragma unroll
        for (int i = 0; i < 16; ++i) SB[sphys(crow(i, h), 32 * nt + r)] = x[i];
      } }
    __builtin_amdgcn_fence(__ATOMIC_ACQ_REL, "wavefront"); __builtin_amdgcn_wave_barrier();
#pragma unroll
    for (int tb = 0; tb < 32; tb += 16) {
      float sre[16], sim[16];
#pragma unroll
      for (int t = 0; t < 16; ++t) { sre[t] = SB[sphys(tb + t, lane)]; sim[t] = SB[sphys(tb + t, 64 + lane)]; }
#pragma unroll
      for (int t = 0; t < 16; ++t) {
        const float nr = ar * hr - ai * hi + sre[t], ni = ar * hi + ai * hr + sim[t];
        hr = nr; hi = ni; sre[t] = hr; sim[t] = hi;
      }
      if (MODE == 1) {
#pragma unroll
        for (int t = 0; t < 16; ++t) { SB[sphys(tb + t, lane)] = sre[t]; SB[sphys(tb + t, 64 + lane)] = sim[t]; }
      }
    }
    __builtin_amdgcn_fence(__ATOMIC_ACQ_REL, "wavefront"); __builtin_amdgcn_wave_barrier();
    if (MODE == 1) {
#pragma unroll
      for (int m2 = 0; m2 < 2; ++m2) {
        const int trow = 16 * m2 + (dir ? 15 - fr : fr);
#pragma unroll
        for (int ks = 0; ks < 4; ++ks) {
          const int c0 = ks * 32 + fq * 8;
          bf16x8 ah, al; split8(*(const float4*)(SB + sphys(trow, c0)), *(const float4*)(SB + sphys(trow, c0 + 4)), 1.f, ah, al);
          Y[2 * hb + m2] = __builtin_amdgcn_mfma_f32_16x16x32_bf16(ah, chh[ks], Y[2 * hb + m2], 0, 0, 0);
          Y[2 * hb + m2] = __builtin_amdgcn_mfma_f32_16x16x32_bf16(ah, chl[ks], Y[2 * hb + m2], 0, 0, 0);
          Y[2 * hb + m2] = __builtin_amdgcn_mfma_f32_16x16x32_bf16(al, chh[ks], Y[2 * hb + m2], 0, 0, 0);
        }
      }
      __builtin_amdgcn_fence(__ATOMIC_ACQ_REL, "wavefront"); __builtin_amdgcn_wave_barrier();
    }
  }
}

DEVI void s5_local_task(const Params& p, int l, int t, int lane, float* SB) {
  const int g = t & 15, n = (t >> 4) % 36, bd = (t >> 4) / 36, dir = bd & 1, b = bd >> 1;
  float hr = 0.f, hi = 0.f; f32x4 Y[4];
  s5_wave_dir<0>(p, (const float*)(p.ws + OFF_P), SB, l, b, g, dir, n, lane, hr, hi, Y);
  float2* SE = (float2*)(p.ws + OFF_YS + (1u << 20));
  SE[((size_t)((b * 16 + g) * 2 + dir) * 36 + n) * 64 + lane] = make_float2(hr, hi);
}
DEVI void s5_out_task(const Params& p, int l, int t, int lane, float* SB) {
  const int g = t & 15, nf = (t >> 4) % 36, b = (t >> 4) / 36, fr = lane & 15, fq = lane >> 4;
  if (l == 3 && nf < 4) return;
  const float* P = (const float*)(p.ws + OFF_P);
  f32x4 Y[4];
#pragma unroll
  for (int i = 0; i < 4; ++i) Y[i] = f32x4{0.f, 0.f, 0.f, 0.f};
#pragma unroll 1
  for (int dir = 0; dir < 2; ++dir) {
    const int n = dir ? mirror_blk(nf) : nf;
    const float2 cin = ((const float2*)(p.ws + OFF_YS + (1u << 20)))[((size_t)((b * 16 + g) * 2 + dir) * 36 + n) * 64 + lane];
    float hr = cin.x, hi = cin.y;
    s5_wave_dir<1>(p, P, SB, l, b, g, dir, n, lane, hr, hi, Y);
    { const f32x4 t0 = Y[0], t1 = Y[1]; Y[0] = Y[3]; Y[1] = Y[2]; Y[2] = t1; Y[3] = t0; }
  }
  const float dv = p.s5_d[l * 256 + g * 16 + fr];
  bf16_t* GA = (bf16_t*)(p.ws + OFF_GA);
#pragma unroll
  for (int mt = 0; mt < 4; ++mt)
#pragma unroll
    for (int j = 0; j < 4; ++j) {
      const int tl = 16 * mt + fq * 4 + j;
      const size_t row = (size_t)seq_row(b, 0, nf * 64 + tl);
      const float u = P[row * DIN + 2048 + g * 16 + fr];
      const float t2 = Y[mt][j] + dv * u;
      GA[row * 256 + g * 16 + fr] = f2bf(t2 * __builtin_amdgcn_rcpf(1.f + __expf(-1.5957691216057308f * (t2 + 0.044715f * t2 * t2 * t2))));
    }
}

__device__ void attn_item(const Params& p, int l, int a) {
  extern __shared__ __attribute__((aligned(16))) unsigned char lds_raw[];
  bf16_t* Ks = (bf16_t*)lds_raw;
  bf16_t* Vt = (bf16_t*)(lds_raw + 128 * 72 * 2);
  const float* P = (const float*)(p.ws + OFF_P);
  const float* RC = (const float*)(p.ws + OFF_ROPE); const float* RS = RC + 1024;
  bf16_t* MIX = (bf16_t*)(p.ws + OFF_MIX);
  int tid = threadIdx.x; asm volatile("" : "+v"(tid));
  const int lane = tid & 63, w = tid >> 6, r = lane & 31, h = lane >> 5;
  const bool lat = a < 512;
  int b, hk, n = 0, t0, qrow0;
  if (lat) { b = a >> 6; const int rem = a & 63; n = rem >> 2; hk = (rem >> 1) & 1; t0 = n * 128 + (rem & 1) * 64; qrow0 = b * 2048 + t0; }
  else { const int c = a - 512; b = c >> 3; hk = (c >> 2) & 1; t0 = (c & 3) * 64; qrow0 = NLAT + b * 256 + t0; }
  const int g = w >> 1, qsub = w & 1, tq = t0 + qsub * 32 + r, qrow = qrow0 + qsub * 32 + r, hq = hk * 4 + g;
  bf16x8 qf[4];
  { const float* qp = P + (size_t)qrow * DIN + 1280 + hq * 64;
#pragma unroll
    for (int a2 = 0; a2 < 2; ++a2) {
      float x1[8], x2[8];
      { const float4 u0 = *(const float4*)(qp + a2 * 32 + 8 * h), u1 = *(const float4*)(qp + a2 * 32 + 8 * h + 4);
        const float4 w0 = *(const float4*)(qp + a2 * 32 + 16 + 8 * h), w1 = *(const float4*)(qp + a2 * 32 + 16 + 8 * h + 4);
        x1[0] = u0.x; x1[1] = u0.y; x1[2] = u0.z; x1[3] = u0.w; x1[4] = u1.x; x1[5] = u1.y; x1[6] = u1.z; x1[7] = u1.w;
        x2[0] = w0.x; x2[1] = w0.y; x2[2] = w0.z; x2[3] = w0.w; x2[4] = w1.x; x2[5] = w1.y; x2[6] = w1.z; x2[7] = w1.w; }
      const int pos = (a2 == 0) ? (tq >> 6) : (tq & 63);
      float cs[8], sn[8];
      { const float4 c0 = *(const float4*)(RC + pos * 16 + 8 * h), c1 = *(const float4*)(RC + pos * 16 + 8 * h + 4);
        const float4 s0 = *(const float4*)(RS + pos * 16 + 8 * h), s1 = *(const float4*)(RS + pos * 16 + 8 * h + 4);
        cs[0] = c0.x; cs[1] = c0.y; cs[2] = c0.z; cs[3] = c0.w; cs[4] = c1.x; cs[5] = c1.y; cs[6] = c1.z; cs[7] = c1.w;
        sn[0] = s0.x; sn[1] = s0.y; sn[2] = s0.z; sn[3] = s0.w; sn[4] = s1.x; sn[5] = s1.y; sn[6] = s1.z; sn[7] = s1.w; }
#pragma unroll
      for (int j = 0; j < 8; ++j) {
        const float c = lat ? cs[j] : 1.f, sv = lat ? sn[j] : 0.f;
        const float o1 = x1[j] * c - x2[j] * sv, o2 = x2[j] * c + x1[j] * sv;
        qf[2 * a2][j] = (short)f2bf(o1 * 0.18033688f); qf[2 * a2 + 1][j] = (short)f2bf(o2 * 0.18033688f);
      }
    } }
  const float sinkv = p.sink[l * 8 + hq] * 1.44269504f;
  float mrun = sinkv, lsum = 0.5f;
  f32x16 O0, O1;
#pragma unroll
  for (int i = 0; i < 16; ++i) { O0[i] = 0.f; O1[i] = 0.f; }
  for (int blk = 0; blk < 5; ++blk) {
    bool kl; int kb;
    if (blk < 3) { if (!lat) continue; kb = n - 1 + blk; if (kb < 0 || kb > 15) continue; kl = true; }
    else { kl = false; kb = blk - 3; }
    __syncthreads();
    {
      const int key = tid >> 2, qd = tid & 3, a2 = qd >> 1, i0 = (qd & 1) * 8;
      const int s = kb * 128 + key;
      const size_t krow = kl ? (size_t)(b * 2048 + s) : (size_t)(NLAT + b * 256 + s);
      const float* kp = P + krow * DIN + 1792 + hk * 64;
      float x1[8], x2[8];
      { const float4 u0 = *(const float4*)(kp + a2 * 32 + i0), u1 = *(const float4*)(kp + a2 * 32 + i0 + 4);
        const float4 w0 = *(const float4*)(kp + a2 * 32 + 16 + i0), w1 = *(const float4*)(kp + a2 * 32 + 16 + i0 + 4);
        x1[0] = u0.x; x1[1] = u0.y; x1[2] = u0.z; x1[3] = u0.w; x1[4] = u1.x; x1[5] = u1.y; x1[6] = u1.z; x1[7] = u1.w;
        x2[0] = w0.x; x2[1] = w0.y; x2[2] = w0.z; x2[3] = w0.w; x2[4] = w1.x; x2[5] = w1.y; x2[6] = w1.z; x2[7] = w1.w; }
      const int pos = (a2 == 0) ? (s >> 6) : (s & 63);
      float cs[8], sn[8];
      { const float4 c0 = *(const float4*)(RC + pos * 16 + i0), c1 = *(const float4*)(RC + pos * 16 + i0 + 4);
        const float4 s0 = *(const float4*)(RS + pos * 16 + i0), s1 = *(const float4*)(RS + pos * 16 + i0 + 4);
        cs[0] = c0.x; cs[1] = c0.y; cs[2] = c0.z; cs[3] = c0.w; cs[4] = c1.x; cs[5] = c1.y; cs[6] = c1.z; cs[7] = c1.w;
        sn[0] = s0.x; sn[1] = s0.y; sn[2] = s0.z; sn[3] = s0.w; sn[4] = s1.x; sn[5] = s1.y; sn[6] = s1.z; sn[7] = s1.w; }
      bf16x8 o1v, o2v;
#pragma unroll
      for (int j = 0; j < 8; ++j) {
        const float c = kl ? cs[j] : 1.f, sv = kl ? sn[j] : 0.f;
        o1v[j] = (short)f2bf(x1[j] * c - x2[j] * sv); o2v[j] = (short)f2bf(x2[j] * c + x1[j] * sv);
      }
      *(bf16x8*)(Ks + key * 72 + a2 * 32 + i0) = o1v; *(bf16x8*)(Ks + key * 72 + a2 * 32 + 16 + i0) = o2v;
      const float* vp = P + krow * DIN + 1920 + hk * 64 + qd * 16;
#pragma unroll
      for (int q = 0; q < 4; ++q) { const float4 v = *(const float4*)(vp + q * 4);
        Vt[(qd * 16 + q * 4 + 0) * 132 + key] = f2bf(v.x); Vt[(qd * 16 + q * 4 + 1) * 132 + key] = f2bf(v.y);
        Vt[(qd * 16 + q * 4 + 2) * 132 + key] = f2bf(v.z); Vt[(qd * 16 + q * 4 + 3) * 132 + key] = f2bf(v.w); }
    }
    __syncthreads();
#pragma unroll 2
    for (int kt = 0; kt < 4; ++kt) {
      if (kl && ((kb == n - 1 && (t0 & 64) && kt < 2) || (kb == n + 1 && !(t0 & 64) && kt >= 2))) continue;
      f32x16 xs;
#pragma unroll
      for (int i = 0; i < 16; ++i) xs[i] = 0.f;
#pragma unroll
      for (int ds = 0; ds < 4; ++ds) { const bf16x8 kf = *(const bf16x8*)(Ks + (kt * 32 + r) * 72 + ds * 16 + 8 * h); xs = __builtin_amdgcn_mfma_f32_32x32x16_bf16(kf, qf[ds], xs, 0, 0, 0); }
      if (kl && kb != n) {
        const int sb = kb * 128 + kt * 32;
#pragma unroll
        for (int i = 0; i < 16; ++i) { const int d = tq - (sb + crow(i, h)); if (d > 128 || d < -128) xs[i] = -1e9f; }
      }
      float tmax = xs[0];
#pragma unroll
      for (int i = 1; i < 16; ++i) tmax = fmaxf(tmax, xs[i]);
      tmax = fmaxf(tmax, shx(tmax, 32, lane));
      if (__builtin_amdgcn_ballot_w64(tmax - mrun > 8.f) != 0ull) {
        const float mnew = fmaxf(mrun, tmax), alpha = __builtin_amdgcn_exp2f(mrun - mnew);
        mrun = mnew; lsum *= alpha;
#pragma unroll
        for (int i = 0; i < 16; ++i) { O0[i] *= alpha; O1[i] *= alpha; }
      }
      float pv[16], psum = 0.f;
#pragma unroll
      for (int i = 0; i < 16; ++i) { pv[i] = __builtin_amdgcn_exp2f(xs[i] - mrun); psum += pv[i]; }
      lsum += psum;
#pragma unroll
      for (int s2 = 0; s2 < 2; ++s2) {
        bf16x8 ps;
#pragma unroll
        for (int j = 0; j < 8; ++j) ps[j] = (short)f2bf(pv[8 * s2 + j]);
        { const bf16_t* vp = Vt + (r) * 132 + kt * 32 + 16 * s2 + 4 * h; const s16x4 lo = *(const s16x4*)vp, hi2 = *(const s16x4*)(vp + 8);
          const bf16x8 va = __builtin_shufflevector(lo, hi2, 0, 1, 2, 3, 4, 5, 6, 7); O0 = __builtin_amdgcn_mfma_f32_32x32x16_bf16(va, ps, O0, 0, 0, 0); }
        { const bf16_t* vp = Vt + (32 + r) * 132 + kt * 32 + 16 * s2 + 4 * h; const s16x4 lo = *(const s16x4*)vp, hi2 = *(const s16x4*)(vp + 8);
          const bf16x8 va = __builtin_shufflevector(lo, hi2, 0, 1, 2, 3, 4, 5, 6, 7); O1 = __builtin_amdgcn_mfma_f32_32x32x16_bf16(va, ps, O1, 0, 0, 0); }
      }
    }
  }
  const float inv = 1.f / (lsum + shx(lsum, 32, lane));
  bf16_t* op = MIX + (size_t)qrow * 1024 + 256 + hq * 64;
#pragma unroll
  for (int gq = 0; gq < 4; ++gq) {
    s16x4 o0, o1;
#pragma unroll
    for (int j = 0; j < 4; ++j) { o0[j] = (short)f2bf(O0[gq * 4 + j] * inv); o1[j] = (short)f2bf(O1[gq * 4 + j] * inv); }
    *(s16x4*)(op + 8 * gq + 4 * h) = o0; *(s16x4*)(op + 32 + 8 * gq + 4 * h) = o1;
  }
  __syncthreads();
}

#define QUEUE_LOOP(CNT, NITEMS, BODY) do { \
    extern __shared__ __attribute__((aligned(16))) unsigned char lds_raw[]; \
    int* slot_ = (int*)(lds_raw + 131072); int* cnt_ = (CNT); const int nit_ = (NITEMS); \
    __syncthreads(); if (threadIdx.x == 0) *slot_ = atomicAdd(cnt_, 1); __syncthreads(); \
    int it = *slot_; \
    while (it < nit_) { \
      int nxt_ = 0; if (threadIdx.x == 0) nxt_ = atomicAdd(cnt_, 1); \
      BODY \
      if (threadIdx.x == 0) *slot_ = nxt_; __syncthreads(); it = *slot_; __syncthreads(); \
    } } while (0)

__device__ void s5_carry_item(const Params& p, int l, int j) {
  int tid = threadIdx.x; asm volatile("" : "+v"(tid));
  const int lane = tid & 63, q = j * 8 + (tid >> 6), dir = q & 1, g = (q >> 1) & 15;
  const int e = (l * 2 + dir) * 16 + g;
  float pr = ((const float*)(p.ws + OFF_ABAR))[(e * 64 + lane) * 2], pi = ((const float*)(p.ws + OFF_ABAR))[(e * 64 + lane) * 2 + 1];
#pragma unroll
  for (int s = 0; s < 6; ++s) { const float t = pr * pr - pi * pi; pi = 2.f * pr * pi; pr = t; }
  float2* SE = (float2*)(p.ws + OFF_YS + (1u << 20)) + (size_t)q * 36 * 64 + lane;
  float hr = 0.f, hi = 0.f;
#pragma unroll 6
  for (int m = 0; m < 36; ++m) { const float2 ev = SE[m * 64]; SE[m * 64] = make_float2(hr, hi); const float t = pr * hr - pi * hi + ev.x; hi = pr * hi + pi * hr + ev.y; hr = t; }
}
__device__ void phase_MA(const Params& p, const Grp gr, int l) {
  extern __shared__ __attribute__((aligned(16))) unsigned char lds_raw[];
  int tid = threadIdx.x; asm volatile("" : "+v"(tid));
  const int lane = tid & 63, w = __builtin_amdgcn_readfirstlane(tid >> 6);
  const int NS = 8 * gr.nloc, s = w * gr.nloc + gr.rank;
  float* LW = (float*)lds_raw + w * 4096;
  const int nbg = (8 - gr.gi + gr.nx - 1) / gr.nx;
#pragma unroll 1
  for (int v = s; v < nbg * 288; v += NS) hgrn_local_task(p, l, 288 * (gr.gi + (v / 288) * gr.nx) + v % 288, lane, LW);
#pragma unroll 1
  for (int v = NS - 1 - s; v < nbg * 1152; v += NS) s5_local_task(p, l, 1152 * (gr.gi + (v / 1152) * gr.nx) + v % 1152, lane, LW);
}
__device__ void phase_MB(const Params& p, const Grp gr, int l) {
  const int nctx = (l < 3) ? 8 : 0;
  for (int b = gr.gi; b < 8; b += gr.nx) {
    QUEUE_LOOP((int*)(p.ws + OFF_CNT) + l * 8 + b, 64 + nctx + 64 + 4,
      if (it < 64) attn_item(p, l, b * 64 + it); else if (it < 64 + nctx) attn_item(p, l, 512 + b * 8 + (it - 64));
      else if (it < 128 + nctx) { hgrn_scan_item(p, b * 64 + (it - 64 - nctx)); __syncthreads(); } else { s5_carry_item(p, l, b * 4 + (it - 128 - nctx)); __syncthreads(); } );
  }
}
__device__ void phase_MC(const Params& p, const Grp gr, int l) {
  extern __shared__ __attribute__((aligned(16))) unsigned char lds_raw[];
  int tid = threadIdx.x; asm volatile("" : "+v"(tid));
  const int lane = tid & 63, w = __builtin_amdgcn_readfirstlane(tid >> 6);
  const int NS = 8 * gr.nloc, s = w * gr.nloc + gr.rank;
  float* LW = (float*)lds_raw + w * 4096;
  const int nbg = (8 - gr.gi + gr.nx - 1) / gr.nx;
#pragma unroll 1
  for (int v = s; v < nbg * 144; v += NS) hgrn_out_task(p, l, 144 * (gr.gi + (v / 144) * gr.nx) + v % 144, lane, LW);
#pragma unroll 1
  for (int v = NS - 1 - s; v < nbg * 576; v += NS) s5_out_task(p, l, 576 * (gr.gi + (v / 576) * gr.nx) + v % 576, lane, LW);
}

#define XB_TMO      128
#define XB_XCNT(j)  (256  + 64 * (j))
#define XB_XSUB(j)  (1280 + 64 * (j))
#define XB_XGEN(j)  (2304 + 64 * (j))
#define XB_TOP      3328
#define XB_TOPGEN   3392
#define XB_LSUB(j)  (3456 + 64 * (j))
#define XB_LGEN(j)  (4480 + 64 * (j))
#define XCD_BAR_WORDS 5504
#define XB_SPIN_CAP (1u << 22)
#define LAS __attribute__((address_space(3)))
DEVI unsigned xb_ld(unsigned* p)              { return __hip_atomic_load(p, __ATOMIC_RELAXED, __HIP_MEMORY_SCOPE_AGENT); }
DEVI unsigned xb_add(unsigned* p, unsigned v) { return __hip_atomic_fetch_add(p, v, __ATOMIC_RELAXED, __HIP_MEMORY_SCOPE_AGENT); }
DEVI unsigned xb_xcc_id() { return (unsigned)__builtin_amdgcn_s_getreg((3 << 11) | 20) & 0xFu; }
#define XB_SPIN(cond, bar) do { unsigned _sp = 0; while (cond) { __builtin_amdgcn_s_sleep(1); \
    if ((++_sp & 255u) == 0u) { if (xb_ld(&(bar)[XB_TMO])) break; if (_sp > XB_SPIN_CAP) { atomicAdd(&(bar)[XB_TMO], 1u); break; } } } } while (0)
struct XcdBarrier { unsigned* bar; unsigned x; volatile LAS unsigned* st; };
DEVI XcdBarrier xcd_barrier_post(unsigned* bar, volatile LAS unsigned* st) {
  XcdBarrier b; b.bar = bar; b.x = xb_xcc_id(); b.st = st;
  if (threadIdx.x == 0) st[3] = xb_add(&bar[XB_XCNT(b.x)], 1u);
  return b;
}
DEVI void xcd_barrier_complete(unsigned* bar, unsigned x, unsigned& nloc, unsigned& nx) {
  const unsigned G = gridDim.x * gridDim.y * gridDim.z;
  unsigned sum, cnt, mine, sp = 0u;
  for (;;) {
    sum = 0u; cnt = 0u; mine = 0u;
#pragma unroll
    for (unsigned j = 0; j < 16; ++j) { const unsigned c = xb_ld(&bar[XB_XCNT(j)]); sum += c; cnt += (c > 0u) ? 1u : 0u; mine = (j == x) ? c : mine; }
    if (sum == G) break;
    __builtin_amdgcn_s_sleep(1);
    if ((++sp & 255u) == 0u) { if (xb_ld(&bar[XB_TMO])) break; if (sp > XB_SPIN_CAP) { atomicAdd(&bar[XB_TMO], 1u); break; } }
  }
  nloc = mine > 0u ? mine : 1u; nx = cnt > 0u ? cnt : 1u;
}
DEVI void xcd_barrier(const XcdBarrier& b) {
  asm volatile("s_waitcnt vmcnt(0)" ::: "memory");
  __syncthreads();
  if (threadIdx.x == 0) {
    unsigned* bar = b.bar;
    __builtin_amdgcn_s_waitcnt(0);
    unsigned nloc = b.st[0], nx = b.st[1];
    if (nloc == 0u) { xcd_barrier_complete(bar, b.x, nloc, nx); b.st[0] = nloc; b.st[1] = nx; }
    const unsigned old = xb_add(&bar[XB_XSUB(b.x)], 1u);
    const unsigned gen = old / nloc;
    if (old + 1u == (gen + 1u) * nloc) {
      __builtin_amdgcn_fence(__ATOMIC_RELEASE, "agent");
      asm volatile("s_waitcnt vmcnt(0)" ::: "memory");
      const unsigned og = xb_add(&bar[XB_TOP], 1u);
      const unsigned tg = og / nx;
      if (og + 1u == (tg + 1u) * nx) xb_add(&bar[XB_TOPGEN], 1u);
      else XB_SPIN(xb_ld(&bar[XB_TOPGEN]) == tg, bar);
      __builtin_amdgcn_fence(__ATOMIC_ACQUIRE, "agent");
      xb_add(&bar[XB_XGEN(b.x)], 1u);
      asm volatile("s_waitcnt vmcnt(0)" ::: "memory");
    } else {
      XB_SPIN(xb_ld(&bar[XB_XGEN(b.x)]) == gen, bar);
      __builtin_amdgcn_fence(__ATOMIC_ACQUIRE, "agent");
      asm volatile("s_waitcnt vmcnt(0)" ::: "memory");
    }
  }
  __syncthreads();
}

DEVI void grp_barrier(const XcdBarrier& b) {
  asm volatile("s_waitcnt vmcnt(0)" ::: "memory");
  __syncthreads();
  if (threadIdx.x == 0) {
    unsigned* bar = b.bar;
    __builtin_amdgcn_s_waitcnt(0);
    const unsigned nloc = b.st[0];
    const unsigned old = xb_add(&bar[XB_LSUB(b.x)], 1u);
    const unsigned gen = old / nloc;
    if (old + 1u == (gen + 1u) * nloc) xb_add(&bar[XB_LGEN(b.x)], 1u);
    else XB_SPIN(xb_ld(&bar[XB_LGEN(b.x)]) == gen, bar);
    __builtin_amdgcn_fence(__ATOMIC_ACQUIRE, "agent");
    asm volatile("s_waitcnt vmcnt(0)" ::: "memory");
  }
  __syncthreads();
}

__global__ void __launch_bounds__(NTHR) mega(Params p) {
  cg::grid_group grid = cg::this_grid();
  phase0(p);
  grid.sync();
  extern __shared__ __attribute__((aligned(16))) unsigned char lds_dyn[];
  volatile LAS unsigned* bst = (volatile LAS unsigned*)(lds_dyn + 131072 + 64);
  if (threadIdx.x < 8) bst[threadIdx.x] = 0u;
  __syncthreads();
  const XcdBarrier xbar = xcd_barrier_post((unsigned*)(p.ws + OFF_BAR), bst);
  xcd_barrier(xbar);
  if (threadIdx.x == 0) {
    unsigned gi = 0u, nx = 0u, nloc = 1u;
    for (unsigned j = 0; j < 16; ++j) { const unsigned c = xb_ld((unsigned*)(p.ws + OFF_BAR) + XB_XCNT(j)); if (c) { ++nx; if (j < xbar.x) ++gi; } if (j == xbar.x) nloc = c ? c : 1u; }
    bst[4] = gi; bst[5] = nx ? nx : 1u; bst[6] = nloc;
  }
  __syncthreads();
  Grp gr;
  gr.gi = __builtin_amdgcn_readfirstlane((int)bst[4]); gr.nx = __builtin_amdgcn_readfirstlane((int)bst[5]);
  gr.rank = __builtin_amdgcn_readfirstlane((int)bst[3]); gr.nloc = __builtin_amdgcn_readfirstlane((int)bst[6]);
  for (int l = 0; l < 4; ++l) {
    const int nMpost = (l < 3) ? 72 : 64;
    for (int s = 0; s < 13; ++s) {
      const int nM = (s < 8) ? 72 : nMpost;
      if (s == 0 || s == 3 || s == 10) {
        const float* MODc = (const float*)(p.ws + OFF_MOD) + 8 * 9216 + 2048;
        const float* pend = nullptr; float pc = 0.5f;
        if (s == 0) { if (l > 0) pend = MODc + (size_t)(l - 1) * 9 * 9216 + 2 * 3072; }
        else if (s == 3) pend = MODc + (size_t)l * 9 * 9216;
        else { if (l < 3) { pend = MODc + (size_t)l * 9 * 9216 + 3072; pc = 1.f; } }
        phase_adaln(p, gr, l, s == 10 ? 2 : s / 3, nM * 256, pend, pc, (l == 0 && s == 0) ? p.x : nullptr, (l == 0 && s <= 3) ? p.ctx : nullptr);
      }
      else if (s == 5) phase_MA(p, gr, l);
      else if (s == 6) phase_MB(p, gr, l);
      else if (s == 7) phase_MC(p, gr, l);
      else {
        bf16_t* H = (bf16_t*)(p.ws + OFF_H); bf16_t* ACT = (bf16_t*)(p.ws + OFF_ACT); float* X = (float*)(p.ws + OFF_X);
        bf16_t* MIX = (bf16_t*)(p.ws + OFF_MIX); bf16_t* GA = (bf16_t*)(p.ws + OFF_GA);
        const float* MOD = (const float*)(p.ws + OFF_MOD) + (size_t)l * 9 * 9216;
        int epi, nN, K; const bf16_t* A; const bf16_t* Bt; EpiArgs ea{nullptr, nullptr, nullptr, 0.f, 0, 0, (float*)(p.ws + OFF_PART), (const float*)(p.ws + OFF_X)};
        if (s == 1 || s == 11) { const int f = (s == 11); epi = 1; A = H; Bt = (const bf16_t*)(p.ws + OFF_W1T) + (size_t)(l * 2 + f) * 5632 * 1024; nN = 22; K = 1024; ea.outb = ACT; ea.ldo = DFF; }
        else if (s == 2 || s == 12) { const int f = (s == 12); epi = 2; A = ACT; Bt = (const bf16_t*)(p.ws + OFF_W2T) + (size_t)(l * 2 + f) * 1024 * 2816; nN = 4; K = 2816; ea.outf = X; ea.aux = MOD + (f ? 2 : 0) * 3072 + 2048; ea.coef = 0.5f; ea.ldo = 1024; if (l == 0 && f == 0) ea.xin = p.x; }
        else if (s == 4) { epi = 0; A = H; Bt = (const bf16_t*)(p.ws + OFF_WINT) + (size_t)l * 2304 * 1024; nN = 9; K = 1024; ea.outf = (float*)(p.ws + OFF_P); ea.ldo = DIN; }
        else if (s == 8) { epi = 3; A = GA; Bt = (const bf16_t*)(p.ws + OFF_GLUT) + (size_t)l * 512 * 256; nN = 2; K = 256; ea.outb = MIX; ea.aux = p.glu_b + l * 512; ea.ldo = 1024; ea.coloff = 768; }
        else { epi = 2; A = MIX; Bt = (const bf16_t*)(p.ws + OFF_WOT) + (size_t)l * 1024 * 1024; nN = 4; K = 1024; ea.outf = X; ea.aux = MOD + 1 * 3072 + 2048; ea.coef = 1.f; ea.ldo = 1024; }
        gemm_phase(gr, epi, A, Bt, nM, nN, K, ea);
      }
      grp_barrier(xbar);
    }
  }
  phase_final(p, gr);
}

extern "C" void kernel_launch(void* const* d_in, const int* in_sizes, int n_in, void* d_out, int out_size, void* d_ws, size_t ws_size, hipStream_t stream) {
  static int grid = 0;
  if (grid == 0) {
    int dev = 0, cus = 0, per_cu = 0;
    hipGetDevice(&dev);
    hipDeviceGetAttribute(&cus, hipDeviceAttributeMultiprocessorCount, dev);
    if (hipFuncSetAttribute((const void*)mega, hipFuncAttributeMaxDynamicSharedMemorySize, LDS_BYTES) != hipSuccess) fprintf(stderr, "hipFuncSetAttribute failed\n");
    if (hipOccupancyMaxActiveBlocksPerMultiprocessor(&per_cu, (const void*)mega, NTHR, LDS_BYTES) != hipSuccess || per_cu < 1) { fprintf(stderr, "occupancy query says %d\n", per_cu); per_cu = 1; }
    (void)hipGetLastError();
    if (cus <= 0) cus = 256;
    grid = cus;
    if (ws_size < WS_END) fprintf(stderr, "workspace too small: %zu < %zu\n", ws_size, (size_t)WS_END);
  }
  Params p{};
  const float** pf = (const float**)&p;
  for (int i = 0; i < 25; ++i) pf[i] = (const float*)d_in[i];
  p.out = (float*)d_out; p.ws = (unsigned char*)d_ws;
  void* args[] = {&p};
  hipError_t e = hipLaunchCooperativeKernel((const void*)mega, dim3(grid), dim3(NTHR), args, LDS_BYTES, stream);
  if (e != hipSuccess) fprintf(stderr, "cooperative launch failed: %s (grid %d)\n", hipGetErrorString(e), grid);
}
```
